# Optimizing an MI355X kernel written in HIP

```python
import functools
import jax, jax.numpy as jnp
from jax import lax
import numpy as np

D_MODEL = 1024
BATCH = 4
SEQ = 4096
DEPTH = 2
DEC_BATCH = 16
DEC_SEQ = 32
PAST_LEN = 1024

CHUNK = 64
D_MIX = D_MODEL
RG_WIDTH = D_MIX // 2
RG_BLOCKS = 8
RG_BLOCK = RG_WIDTH // RG_BLOCKS
CONV_W = 4
RG_C = 8.0
RET_HEADS = 4
RET_DK = 64
RET_DV = 64
RET_QK = RET_HEADS * RET_DK
RET_WIDTH = RET_HEADS * RET_DV
HG_HEADS = 4
HG_DK = 64
HG_DV = 64
HG_QK = HG_HEADS * HG_DK
HG_WIDTH = HG_HEADS * HG_DV
ROPE_BASE = 10000.0
LN_EPS = 1e-5
F_EPS = 1e-6
DN_ALPHA = (2 * DEPTH) ** 0.25
DN_BETA = (8 * DEPTH) ** -0.25
SPLITS = (RG_WIDTH, RG_WIDTH, RET_QK, RET_QK, RET_WIDTH, RET_WIDTH, HG_QK, HG_QK, HG_WIDTH, HG_WIDTH)
D_IN = sum(SPLITS)
SPLIT_IDX = tuple(int(v) for v in np.cumsum(SPLITS)[:-1])

kernel_name = "hymba_rglru_retention_hgrn2_deepnorm_stream"


def _layer_norm(x, g, b):
    xf = x.astype(jnp.float32)
    mu = xf.mean(-1, keepdims=True)
    var = jnp.mean(jnp.square(xf - mu), -1, keepdims=True)
    return ((xf - mu) * lax.rsqrt(var + LN_EPS) * g + b).astype(x.dtype)


def _head_layernorm(o, g):
    mu = o.mean(-1, keepdims=True)
    var = jnp.mean(jnp.square(o - mu), -1, keepdims=True)
    y = (o - mu) * lax.rsqrt(var + LN_EPS)
    return y.reshape(o.shape[0], o.shape[1], -1) * g


def _head_rmsnorm(o, g):
    y = o * lax.rsqrt(jnp.mean(jnp.square(o), -1, keepdims=True) + LN_EPS)
    return y.reshape(o.shape[0], o.shape[1], -1) * g


def _rotary(x, pos):
    half = x.shape[-1] // 2
    inv = ROPE_BASE ** (-jnp.arange(half, dtype=jnp.float32) / half)
    ang = pos.astype(jnp.float32)[:, None] * inv[None, :]
    cos = jnp.cos(ang)[None, :, None, :]
    sin = jnp.sin(ang)[None, :, None, :]
    x1, x2 = x[..., :half], x[..., half:]
    return jnp.concatenate([x1 * cos - x2 * sin, x2 * cos + x1 * sin], axis=-1)


def _causal_conv(u, buf, w, b):
    L = u.shape[1]
    full = jnp.concatenate([buf, u], axis=1)
    y = b
    for j in range(CONV_W):
        y = y + full[:, j:j + L] * w[j]
    return y, full[:, -(CONV_W - 1):]


def _lin_combine(e1, e2):
    a1, b1 = e1
    a2, b2 = e2
    return a1 * a2, a2 * b1 + b2


def _rglru(u, h0, wa, ba, wx, bx, lam):
    bsz, L, _ = u.shape
    ub = u.reshape(bsz, L, RG_BLOCKS, RG_BLOCK)
    r = jax.nn.sigmoid(jnp.einsum('blgi,gij->blgj', ub, wa).reshape(bsz, L, RG_WIDTH) + ba)
    gi = jax.nn.sigmoid(jnp.einsum('blgi,gij->blgj', ub, wx).reshape(bsz, L, RG_WIDTH) + bx)
    log_a = RG_C * r * jax.nn.log_sigmoid(lam.astype(jnp.float32))
    a = jnp.exp(log_a)
    b = jnp.sqrt(-jnp.expm1(2.0 * log_a)) * (gi * u)
    a_cum, b_cum = lax.associative_scan(_lin_combine, (a, b), axis=1)
    h = a_cum * h0[:, None, :] + b_cum
    return h, h[:, -1]


def _retention_chunk(S, q, k, v, log_g):
    L = q.shape[1]
    j = jnp.arange(L, dtype=jnp.float32)
    rel = j[:, None] - j[None, :]
    dmat = jnp.where(rel[None] >= 0, jnp.exp(jnp.maximum(rel, 0.0)[None] * log_g[:, None, None]), 0.0)
    scores = jnp.einsum('blhd,bshd->bhls', q, k) * dmat[None]
    intra = jnp.einsum('bhls,bshv->blhv', scores, v)
    cross = jnp.einsum('blhd,bhdv->blhv', q, S) * jnp.exp((j[:, None] + 1.0) * log_g[None, :])[None, :, :, None]
    k_dec = k * jnp.exp((L - 1.0 - j)[:, None] * log_g[None, :])[None, :, :, None]
    S_new = jnp.exp(L * log_g)[None, :, None, None] * S + jnp.einsum('bshd,bshv->bhdv', k_dec, v)
    return S_new, intra + cross


def _hgrn2_chunk(S, q, k, v, log_f):
    L = q.shape[1]
    cum = jnp.cumsum(log_f, axis=1)
    tri = jnp.tril(jnp.ones((L, L), dtype=bool))[None, :, :, None, None]
    diff = cum[:, :, None] - cum[:, None, :]
    decay = jnp.where(tri, jnp.exp(jnp.minimum(diff, 0.0)), 0.0)
    scores = jnp.einsum('bthd,btshd,bshd->bhts', q, decay, k)
    intra = jnp.einsum('bhts,bshv->bthv', scores, v)
    cross = jnp.einsum('bthd,bhdv->bthv', q * jnp.exp(cum), S)
    last = cum[:, -1]
    k_dec = k * jnp.exp(last[:, None] - cum)
    S_new = jnp.exp(last)[..., None] * S + jnp.einsum('bshd,bshv->bhdv', k_dec, v)
    return S_new, intra + cross


def _chunkwise(step, S0, seqs):
    L = seqs[0].shape[1]
    if L <= CHUNK:
        return step(S0, *seqs)
    n = L // CHUNK

    def to_chunks(a):
        return jnp.moveaxis(a.reshape(a.shape[0], n, CHUNK, *a.shape[2:]), 1, 0)

    S, o = lax.scan(lambda S, xs: step(S, *xs), S0, tuple(to_chunks(a) for a in seqs))
    o = jnp.moveaxis(o, 0, 1)
    return S, o.reshape(o.shape[0], L, *o.shape[3:])


def _layer(x, conv_buf, h_rg, s_ret, s_hg, pos, lb, w_in, conv_w, conv_b, rg_wa, rg_ba, rg_wx, rg_bx,
           rg_lam, ret_gn_g, hg_bf, hg_norm_g, w_out, ln_g, ln_b):
    f32 = jnp.float32
    bsz, L, _ = x.shape
    proj = jnp.einsum('bld,de->ble', x, w_in)
    rg_x, rg_gate, r_q, r_k, r_v, r_gate, h_q, h_f, h_i, h_gate = jnp.split(proj, SPLIT_IDX, axis=-1)
    u, conv_new = _causal_conv(rg_x, conv_buf, conv_w, conv_b)
    h, h_last = _rglru(u.astype(f32), h_rg.astype(f32), rg_wa, rg_ba, rg_wx, rg_bx, rg_lam)
    y_a = h * jax.nn.silu(rg_gate.astype(f32))
    q = _rotary(r_q.astype(f32).reshape(bsz, L, RET_HEADS, RET_DK), pos) * RET_DK ** -0.5
    k = _rotary(r_k.astype(f32).reshape(bsz, L, RET_HEADS, RET_DK), pos)
    v = r_v.astype(f32).reshape(bsz, L, RET_HEADS, RET_DV)
    log_g = jnp.log1p(-jnp.exp2(-5.0 - jnp.arange(RET_HEADS, dtype=f32)))
    s_ret_new, o_b = _chunkwise(functools.partial(_retention_chunk, log_g=log_g), s_ret.astype(f32), (q, k, v))
    y_b = _head_layernorm(o_b, ret_gn_g) * jax.nn.silu(r_gate.astype(f32))
    z = h_f.astype(f32) + hg_bf
    f = lb + (1.0 - lb) * jax.nn.sigmoid(z)
    log_f = jnp.log(jnp.maximum(f, F_EPS))
    k_c = (1.0 - lb) * jax.nn.sigmoid(-z)
    shp = (bsz, L, HG_HEADS, HG_DK)
    s_hg_new, o_c = _chunkwise(_hgrn2_chunk, s_hg.astype(f32),
                               (h_q.astype(f32).reshape(shp), k_c.reshape(shp),
                                h_i.astype(f32).reshape(bsz, L, HG_HEADS, HG_DV), log_f.reshape(shp)))
    y_c = _head_rmsnorm(o_c, hg_norm_g) * jax.nn.silu(h_gate.astype(f32))
    y = jnp.einsum('ble,ed->bld', jnp.concatenate([y_a, y_b, y_c], axis=-1).astype(x.dtype), w_out)
    x_new = _layer_norm(DN_ALPHA * x + y, ln_g, ln_b)
    return x_new, conv_new, h_last, s_ret_new, s_hg_new


def setup_inputs(seed: int = 0) -> dict:
    key = jax.random.key(seed)
    ks = jax.random.split(key, 24)
    f32 = jnp.float32
    nrm = lambda k, shp, s: jax.random.normal(k, shp, f32) * s
    u = jax.random.uniform(ks[10], (DEPTH, RG_WIDTH), f32, 0.9, 0.999)
    s = u ** (1.0 / RG_C)
    return {
        'x_prompt': nrm(ks[0], (BATCH, SEQ, D_MODEL), 1.0),
        'x_sample': nrm(ks[1], (DEC_BATCH, DEC_SEQ, D_MODEL), 1.0),
        'cache_conv': nrm(ks[2], (DEPTH, DEC_BATCH, CONV_W - 1, RG_WIDTH), 1.0),
        'state_rglru': nrm(ks[3], (DEPTH, DEC_BATCH, RG_WIDTH), 1.0),
        'state_ret': nrm(ks[4], (DEPTH, DEC_BATCH, RET_HEADS, RET_DK, RET_DV), 4.0),
        'state_hgrn': nrm(ks[5], (DEPTH, DEC_BATCH, HG_HEADS, HG_DK, HG_DV), 1.0),
        'w_in': nrm(ks[6], (DEPTH, D_MODEL, D_IN), D_MODEL ** -0.5),
        'conv_w': nrm(ks[7], (DEPTH, CONV_W, RG_WIDTH), CONV_W ** -0.5),
        'conv_b': nrm(ks[8], (DEPTH, RG_WIDTH), 0.02),
        'rg_wa': nrm(ks[9], (DEPTH, RG_BLOCKS, RG_BLOCK, RG_BLOCK), RG_BLOCK ** -0.5),
        'rg_ba': nrm(ks[11], (DEPTH, RG_WIDTH), 0.02),
        'rg_wx': nrm(ks[12], (DEPTH, RG_BLOCKS, RG_BLOCK, RG_BLOCK), RG_BLOCK ** -0.5),
        'rg_bx': nrm(ks[13], (DEPTH, RG_WIDTH), 0.02),
        'rg_lambda': jnp.log(s) - jnp.log1p(-s),
        'ret_gn_g': 1.0 + nrm(ks[14], (DEPTH, RET_WIDTH), 0.02),
        'hg_bf': nrm(ks[15], (DEPTH, HG_QK), 0.1),
        'hg_lb_logits': 1.0 + nrm(ks[16], (DEPTH, HG_QK), 0.1),
        'hg_norm_g': 1.0 + nrm(ks[17], (DEPTH, HG_WIDTH), 0.02),
        'w_out': nrm(ks[18], (DEPTH, D_MIX, D_MODEL), DN_BETA * D_MIX ** -0.5),
        'ln_g': 1.0 + nrm(ks[19], (DEPTH, D_MODEL), 0.02),
        'ln_b': nrm(ks[20], (DEPTH, D_MODEL), 0.02),
    }


def reference(x_prompt, x_sample, cache_conv, state_rglru, state_ret, state_hgrn, w_in, conv_w, conv_b,
              rg_wa, rg_ba, rg_wx, rg_bx, rg_lambda, ret_gn_g, hg_bf, hg_lb_logits, hg_norm_g, w_out,
              ln_g, ln_b):
    f32 = jnp.float32
    lb_p = jax.nn.softmax(hg_lb_logits.astype(f32), axis=0)
    lb_all = jnp.cumsum(lb_p, axis=0) - lb_p[0]
    bp, lp = x_prompt.shape[0], x_prompt.shape[1]
    ls = x_sample.shape[1]
    pos_p = jnp.arange(lp, dtype=jnp.int32)
    pos_s = PAST_LEN + jnp.arange(ls, dtype=jnp.int32)
    xp, xs = x_prompt, x_sample
    conv_p, rg_p, ret_p, hg_p = [], [], [], []
    conv_s, rg_s, ret_s, hg_s = [], [], [], []
    for l in range(DEPTH):
        params = (w_in[l], conv_w[l], conv_b[l], rg_wa[l], rg_ba[l], rg_wx[l], rg_bx[l], rg_lambda[l],
                  ret_gn_g[l], hg_bf[l], hg_norm_g[l], w_out[l], ln_g[l], ln_b[l])
        xp, c1, r1, s1, g1 = _layer(
            xp, jnp.zeros((bp, CONV_W - 1, RG_WIDTH), xp.dtype), jnp.zeros((bp, RG_WIDTH), f32),
            jnp.zeros((bp, RET_HEADS, RET_DK, RET_DV), f32), jnp.zeros((bp, HG_HEADS, HG_DK, HG_DV), f32),
            pos_p, lb_all[l], *params)
        xs, c2, r2, s2, g2 = _layer(
            xs, cache_conv[l], state_rglru[l], state_ret[l], state_hgrn[l], pos_s, lb_all[l], *params)
        conv_p.append(c1); rg_p.append(r1); ret_p.append(s1); hg_p.append(g1)
        conv_s.append(c2); rg_s.append(r2); ret_s.append(s2); hg_s.append(g2)
    return (xp, xs, jnp.stack(conv_p), jnp.stack(rg_p), jnp.stack(ret_p), jnp.stack(hg_p),
            jnp.stack(conv_s), jnp.stack(rg_s), jnp.stack(ret_s), jnp.stack(hg_s))
```

```cpp
#include <hip/hip_runtime.h>
#include <cstdio>
#include <cstdint>

typedef unsigned short bf16_t;
constexpr int D = 1024, NB = 4, SEQ = 4096, DEPTH = 2, DB = 16, DS = 32, PAST = 1024;
constexpr int MP = NB * SEQ, MS = DB * DS, M = MP + MS;
constexpr int DIN = 3072, NSEQ = NB + DB;
constexpr int C_RGX = 0, C_RGG = 512, C_RQ = 1024, C_RK = 1280, C_RV = 1536, C_RG = 1792, C_HQ = 2048, C_HF = 2304, C_HI = 2560, C_HG = 2816;
constexpr size_t O_YP = 0, O_YS = O_YP + (size_t)MP * D, O_CP = O_YS + (size_t)MS * D, O_RP = O_CP + 2 * 4 * 3 * 512, O_TP = O_RP + 2 * 4 * 512,
                 O_HP = O_TP + 2 * 4 * 4 * 4096, O_CS = O_HP + 2 * 4 * 4 * 4096, O_RS = O_CS + 2 * 16 * 3 * 512, O_TS = O_RS + 2 * 16 * 512,
                 O_HS = O_TS + 2 * 16 * 4 * 4096, O_END = O_HS + 2 * 16 * 4 * 4096;
static_assert(O_END == 18694144, "output size");
constexpr float LN_EPS = 1e-5f, F_EPS = 1e-6f;
constexpr float DN_ALPHA = 1.41421356237309515f;

constexpr size_t MiB = 1u << 20;
constexpr size_t WS_XN = 2 * MiB, WS_PROJ = 36 * MiB, WS_YMIX = 136 * MiB, WS_X1 = 170 * MiB;

__device__ __forceinline__ float bf2f(bf16_t v) { return __uint_as_float((unsigned)v << 16); }
__device__ __forceinline__ bf16_t f2bf(float f) { unsigned u = __float_as_uint(f); return (bf16_t)((u + 0x7fffu + ((u >> 16) & 1u)) >> 16); }
__device__ __forceinline__ float sigmoidf_(float x) { return 1.f / (1.f + __expf(-x)); }
__host__ __device__ inline int seq_row0(int q) { return q < NB ? q * SEQ : MP + (q - NB) * DS; }
__host__ __device__ inline int seq_len(int q) { return q < NB ? SEQ : DS; }
__device__ __forceinline__ float wave_sum(float v) {
#pragma unroll
    for (int o = 1; o < 64; o <<= 1) v += __shfl_xor(v, o);
    return v;
}

__global__ void __launch_bounds__(256) k_cvt_x(const float* xp, const float* xs, bf16_t* xn) {
    const size_t n = (size_t)M * D;
    for (size_t i = (size_t)blockIdx.x * 256 + threadIdx.x; i < n; i += (size_t)gridDim.x * 256) {
        const float v = i < (size_t)MP * D ? xp[i] : xs[i - (size_t)MP * D];
        xn[i] = f2bf(v);
    }
}

template <bool OUT_BF16>
__global__ void __launch_bounds__(256) k_gemm_naive(const bf16_t* A, const float* W, void* out, int N, int K) {
    __shared__ float sA[16][68];
    __shared__ float sB[16][68];
    const int bm = blockIdx.y * 64, bn = blockIdx.x * 64, tid = threadIdx.x, tx = tid & 15, ty = tid >> 4;
    float acc[4][4];
#pragma unroll
    for (int i = 0; i < 4; ++i)
#pragma unroll
        for (int j = 0; j < 4; ++j) acc[i][j] = 0.f;
    for (int k0 = 0; k0 < K; k0 += 16) {
#pragma unroll
        for (int it = 0; it < 4; ++it) { const int i = tid + it * 256; const int m = i >> 4, k = i & 15; sA[k][m] = bf2f(A[(size_t)(bm + m) * K + k0 + k]); }
#pragma unroll
        for (int it = 0; it < 4; ++it) { const int i = tid + it * 256; const int k = i >> 6, n = i & 63; sB[k][n] = W[(size_t)(k0 + k) * N + bn + n]; }
        __syncthreads();
#pragma unroll
        for (int k = 0; k < 16; ++k) {
            float a[4], b[4];
#pragma unroll
            for (int i = 0; i < 4; ++i) { a[i] = sA[k][ty * 4 + i]; b[i] = sB[k][tx * 4 + i]; }
#pragma unroll
            for (int i = 0; i < 4; ++i)
#pragma unroll
                for (int j = 0; j < 4; ++j) acc[i][j] += a[i] * b[j];
        }
        __syncthreads();
    }
#pragma unroll
    for (int i = 0; i < 4; ++i)
#pragma unroll
        for (int j = 0; j < 4; ++j) {
            const size_t o = (size_t)(bm + ty * 4 + i) * N + bn + tx * 4 + j;
            if (OUT_BF16) ((bf16_t*)out)[o] = f2bf(acc[i][j]); else ((float*)out)[o] = acc[i][j];
        }
}

__global__ void __launch_bounds__(64) k_rg_naive(const bf16_t* proj, bf16_t* ymix, const float* cache_conv, const float* state_rg, const float* conv_w, const float* conv_b,
                                                 const float* wa, const float* ba, const float* wx, const float* bx, const float* lam, float* out, int layer) {
    const int q = blockIdx.x / 8, g = blockIdx.x % 8, tid = threadIdx.x, c = g * 64 + tid;
    const int row0 = seq_row0(q), L = seq_len(q);
    __shared__ float su[64];
    float xm1 = 0.f, xm2 = 0.f, xm3 = 0.f, h = 0.f;
    if (q >= NB) { const int b = q - NB; xm3 = cache_conv[((size_t)b * 3 + 0) * 512 + c]; xm2 = cache_conv[((size_t)b * 3 + 1) * 512 + c]; xm1 = cache_conv[((size_t)b * 3 + 2) * 512 + c]; h = state_rg[b * 512 + c]; }
    const float w0 = conv_w[0 * 512 + c], w1 = conv_w[1 * 512 + c], w2 = conv_w[2 * 512 + c], w3 = conv_w[3 * 512 + c], cb = conv_b[c];
    const float lm = lam[c];
    const float ls = -log1pf(__expf(-lm));
    const float bac = ba[c], bxc = bx[c];
    float wra[64], wrx[64];
#pragma unroll
    for (int i = 0; i < 64; ++i) { wra[i] = wa[((size_t)g * 64 + i) * 64 + tid]; wrx[i] = wx[((size_t)g * 64 + i) * 64 + tid]; }
    for (int t = 0; t < L; ++t) {
        const bf16_t* pr = proj + (size_t)(row0 + t) * DIN;
        const float x0 = bf2f(pr[C_RGX + c]);
        const float u = cb + w0 * xm3 + w1 * xm2 + w2 * xm1 + w3 * x0;
        xm3 = xm2; xm2 = xm1; xm1 = x0;
        su[tid] = u;
        __syncthreads();
        float ra = bac, rx = bxc;
#pragma unroll
        for (int i = 0; i < 64; ++i) { const float ui = su[i]; ra += ui * wra[i]; rx += ui * wrx[i]; }
        __syncthreads();
        const float r = sigmoidf_(ra), gi = sigmoidf_(rx);
        const float log_a = 8.f * r * ls;
        const float a = __expf(log_a);
        const float bb = sqrtf(-expm1f(2.f * log_a)) * (gi * u);
        h = a * h + bb;
        const float gt = bf2f(pr[C_RGG + c]);
        ymix[(size_t)(row0 + t) * D + c] = f2bf(h * gt * sigmoidf_(gt));
    }
    if (q < NB) {
        out[O_RP + ((size_t)layer * 4 + q) * 512 + c] = h;
        float* cp = out + O_CP + ((size_t)layer * 4 + q) * 3 * 512;
        cp[0 * 512 + c] = xm3; cp[1 * 512 + c] = xm2; cp[2 * 512 + c] = xm1;
    } else {
        const int b = q - NB;
        out[O_RS + ((size_t)layer * 16 + b) * 512 + c] = h;
        float* cp = out + O_CS + ((size_t)layer * 16 + b) * 3 * 512;
        cp[0 * 512 + c] = xm3; cp[1 * 512 + c] = xm2; cp[2 * 512 + c] = xm1;
    }
}

template <bool HG>
__global__ void __launch_bounds__(256) k_lin_naive(const bf16_t* proj, bf16_t* ymix, const float* state0, const float* norm_g, const float* hg_bf, const float* lb_logits, float* out, int layer) {
    const int q = blockIdx.x / 4, h = blockIdx.x % 4, tid = threadIdx.x, e = tid & 63, dq = tid >> 6;
    const int row0 = seq_row0(q), L = seq_len(q), posbase = q < NB ? 0 : PAST;
    __shared__ float sq[64], sk[64], sv[64], sdec[64], spart[4][64];
    float S[16];
#pragma unroll
    for (int i = 0; i < 16; ++i) S[i] = (q < NB) ? 0.f : state0[(((size_t)(q - NB) * 4 + h) * 64 + dq * 16 + i) * 64 + e];
    const float lg = log1pf(-exp2f(-5.f - (float)h)), gdec = __expf(lg);
    float lb = 0.f, bfd = 0.f, inv = 0.f;
    if (tid < 64) {
        if (HG) { if (layer == 1) lb = 1.f / (1.f + __expf(lb_logits[h * 64 + tid] - lb_logits[256 + h * 64 + tid])); bfd = hg_bf[h * 64 + tid]; }
        else inv = exp2f(-(float)(tid & 31) * (13.287712379549449f / 32.f));
    }
    const float ng = norm_g[h * 64 + e];
    for (int t = 0; t < L; ++t) {
        const int row = row0 + t;
        const bf16_t* pr = proj + (size_t)row * DIN;
        if (tid < 64) {
            const int d = tid;
            if (!HG) {
                const int i = d & 31;
                const float ang = (float)(posbase + t) * inv;
                float sn, cs; sincosf(ang, &sn, &cs);
                const float q1 = bf2f(pr[C_RQ + h * 64 + i]), q2 = bf2f(pr[C_RQ + h * 64 + 32 + i]);
                const float k1 = bf2f(pr[C_RK + h * 64 + i]), k2 = bf2f(pr[C_RK + h * 64 + 32 + i]);
                sq[d] = 0.125f * (d < 32 ? q1 * cs - q2 * sn : q2 * cs + q1 * sn);
                sk[d] = d < 32 ? k1 * cs - k2 * sn : k2 * cs + k1 * sn;
                sv[d] = bf2f(pr[C_RV + h * 64 + d]);
                sdec[d] = gdec;
            } else {
                const float z = bf2f(pr[C_HF + h * 64 + d]) + bfd;
                const float sg = 1.f / (1.f + __expf(-z)), sgn = 1.f / (1.f + __expf(z));
                sq[d] = bf2f(pr[C_HQ + h * 64 + d]);
                sk[d] = (1.f - lb) * sgn;
                sv[d] = bf2f(pr[C_HI + h * 64 + d]);
                sdec[d] = fmaxf(lb + (1.f - lb) * sg, F_EPS);
            }
        }
        __syncthreads();
        const float ve = sv[e];
        float part = 0.f;
#pragma unroll
        for (int i = 0; i < 16; ++i) { const int d = dq * 16 + i; S[i] = sdec[d] * S[i] + sk[d] * ve; part += sq[d] * S[i]; }
        spart[dq][e] = part;
        __syncthreads();
        if (tid < 64) {
            const float o = (spart[0][e] + spart[1][e]) + (spart[2][e] + spart[3][e]);
            float y;
            if (!HG) { const float mu = wave_sum(o) * (1.f / 64.f); const float dl = o - mu; const float var = wave_sum(dl * dl) * (1.f / 64.f); y = dl * rsqrtf(var + LN_EPS); }
            else { const float ms = wave_sum(o * o) * (1.f / 64.f); y = o * rsqrtf(ms + LN_EPS); }
            const float gt = bf2f(pr[(HG ? C_HG : C_RG) + h * 64 + e]);
            ymix[(size_t)row * D + (HG ? 768 : 512) + h * 64 + e] = f2bf(y * ng * gt * sigmoidf_(gt));
        }
    }
    float* so = (q < NB) ? out + (HG ? O_HP : O_TP) + (((size_t)layer * 4 + q) * 4 + h) * 4096 : out + (HG ? O_HS : O_TS) + (((size_t)layer * 16 + (q - NB)) * 4 + h) * 4096;
#pragma unroll
    for (int i = 0; i < 16; ++i) so[(dq * 16 + i) * 64 + e] = S[i];
}

__global__ void __launch_bounds__(256) k_ln_naive(const float* xres_p, const float* xres_s, const float* Y, const float* lg, const float* lbv, float* xout, bf16_t* xn) {
    const int r = blockIdx.x, tid = threadIdx.x;
    const float* xr = r < MP ? xres_p + (size_t)r * D : xres_s + (size_t)(r - MP) * D;
    __shared__ float red[4];
    float v[4]; float s = 0.f;
#pragma unroll
    for (int j = 0; j < 4; ++j) { const int c = tid + 256 * j; v[j] = DN_ALPHA * xr[c] + Y[(size_t)r * D + c]; s += v[j]; }
    s = wave_sum(s); if ((tid & 63) == 0) red[tid >> 6] = s; __syncthreads();
    const float mu = (red[0] + red[1] + red[2] + red[3]) * (1.f / D);
    __syncthreads();
    float s2 = 0.f;
#pragma unroll
    for (int j = 0; j < 4; ++j) { v[j] -= mu; s2 += v[j] * v[j]; }
    s2 = wave_sum(s2); if ((tid & 63) == 0) red[tid >> 6] = s2; __syncthreads();
    const float rstd = rsqrtf((red[0] + red[1] + red[2] + red[3]) * (1.f / D) + LN_EPS);
#pragma unroll
    for (int j = 0; j < 4; ++j) { const int c = tid + 256 * j; const float o = v[j] * rstd * lg[c] + lbv[c]; xout[(size_t)r * D + c] = o; xn[(size_t)r * D + c] = f2bf(o); }
}

extern "C" void kernel_launch(void* const* d_in, const int* in_sizes, int n_in, void* d_out, int out_size, void* d_ws, size_t ws_size, hipStream_t stream) {
    const float* const* in = (const float* const*)d_in;
    unsigned char* ws = (unsigned char*)d_ws;
    float* out = (float*)d_out;
    bf16_t* XN = (bf16_t*)(ws + WS_XN); bf16_t* PROJ = (bf16_t*)(ws + WS_PROJ); bf16_t* YMIX = (bf16_t*)(ws + WS_YMIX); float* X1 = (float*)(ws + WS_X1);
    float* Y = (float*)(ws + WS_PROJ);
    k_cvt_x<<<2048, 256, 0, stream>>>(in[0], in[1], XN);
    for (int l = 0; l < DEPTH; ++l) {
        k_gemm_naive<true><<<dim3(DIN / 64, M / 64), 256, 0, stream>>>(XN, in[6] + (size_t)l * D * DIN, PROJ, DIN, D);
        k_rg_naive<<<NSEQ * 8, 64, 0, stream>>>(PROJ, YMIX, in[2] + (size_t)l * 16 * 3 * 512, in[3] + (size_t)l * 16 * 512, in[7] + l * 4 * 512, in[8] + l * 512,
                                                in[9] + (size_t)l * 8 * 64 * 64, in[10] + l * 512, in[11] + (size_t)l * 8 * 64 * 64, in[12] + l * 512, in[13] + l * 512, out, l);
        k_lin_naive<false><<<NSEQ * 4, 256, 0, stream>>>(PROJ, YMIX, in[4] + (size_t)l * 16 * 4 * 4096, in[14] + l * 256, nullptr, nullptr, out, l);
        k_lin_naive<true><<<NSEQ * 4, 256, 0, stream>>>(PROJ, YMIX, in[5] + (size_t)l * 16 * 4 * 4096, in[17] + l * 256, in[15] + l * 256, in[16], out, l);
        k_gemm_naive<false><<<dim3(D / 64, M / 64), 256, 0, stream>>>(YMIX, in[18] + (size_t)l * D * D, Y, D, D);
        if (l == 0) k_ln_naive<<<M, 256, 0, stream>>>(in[0], in[1], Y, in[19], in[20], X1, XN);
        else k_ln_naive<<<M, 256, 0, stream>>>(X1, X1 + (size_t)MP * D, Y, in[19] + D, in[20] + D, out, XN);
    }
}
```

```cpp
#include <hip/hip_runtime.h>
#include <cstdio>
#include <cstdint>

typedef unsigned short bf16_t;
constexpr int D = 1024, NB = 4, SEQ = 4096, DEPTH = 2, DB = 16, DS = 32, PAST = 1024;
constexpr int MP = NB * SEQ, MS = DB * DS, M = MP + MS;
constexpr int DIN = 3072, NSEQ = NB + DB;
constexpr int C_RGX = 0, C_RGG = 512, C_RQ = 1024, C_RK = 1280, C_RV = 1536, C_RG = 1792, C_HQ = 2048, C_HF = 2304, C_HI = 2560, C_HG = 2816;
constexpr size_t O_YP = 0, O_YS = O_YP + (size_t)MP * D, O_CP = O_YS + (size_t)MS * D, O_RP = O_CP + 2 * 4 * 3 * 512, O_TP = O_RP + 2 * 4 * 512,
                 O_HP = O_TP + 2 * 4 * 4 * 4096, O_CS = O_HP + 2 * 4 * 4 * 4096, O_RS = O_CS + 2 * 16 * 3 * 512, O_TS = O_RS + 2 * 16 * 512,
                 O_HS = O_TS + 2 * 16 * 4 * 4096, O_END = O_HS + 2 * 16 * 4 * 4096;
static_assert(O_END == 18694144, "output size");
#ifndef PANEL_SEAM
#define PANEL_SEAM 1
#endif
#ifndef PG8_WGM
#define PG8_WGM 8
#endif
#ifndef MIX_IGLP
#define MIX_IGLP -1
#endif
#ifndef FINAL_LN_INLINE
#define FINAL_LN_INLINE 1
#endif
#ifndef GIN_ALIGN
#define GIN_ALIGN true
#endif
#ifndef GIN_SP2
#define GIN_SP2 true
#endif
#ifndef PROBE_MFMA
#define PROBE_MFMA 0
#endif
#ifndef PROBE_PK
#define PROBE_PK 0
#endif
#ifndef PROBE_STORE2
#define PROBE_STORE2 0
#endif
#ifndef PROBE_VALU
#define PROBE_VALU 0
#endif
constexpr float LN_EPS = 1e-5f, F_EPS = 1e-6f;
constexpr float DN_ALPHA = 1.41421356237309515f;

constexpr size_t MiB = 1u << 20;
constexpr size_t WS_CTL = 0, CTL_ZERO_BYTES = 1 * MiB;
constexpr size_t WS_XBUF = 1 * MiB;
constexpr size_t XBUF_LAYER = (size_t)M * 4 * 8;
constexpr size_t WS_XN = 4 * MiB;
constexpr size_t WS_PROJ = 37 * MiB;
constexpr size_t WS_YMIX = 136 * MiB;
constexpr size_t WS_ST = 170 * MiB;
constexpr size_t WS_P = 187 * MiB;
constexpr size_t WS_HL = 204 * MiB;
constexpr size_t WS_YPRE = 221 * MiB;
constexpr size_t WS_X1S = 224 * MiB;
constexpr size_t WS_WIN = 236 * MiB;
constexpr size_t WS_WOUT = 248 * MiB;
constexpr size_t WS_MISC = 252 * MiB;
constexpr size_t WS_END = 256 * MiB;
static_assert(WS_XBUF + 2 * XBUF_LAYER <= WS_XN && WS_XN + (size_t)M * D * 2 <= WS_PROJ && WS_PROJ + (size_t)M * DIN * 2 <= WS_YMIX && WS_P + (size_t)M * 512 * 2 <= WS_HL && WS_HL + (size_t)M * 512 * 2 <= WS_WIN, "ws map");
constexpr int CW_TMO = 0, CW_CODE = 1, CW_BAR = 4096, CW_SEAM = 16384, SEAM_BANK = 128 * 64, CW_SAMP = 40960, CW_PDONE = 49152;
static_assert((size_t)(CW_SEAM + 2 * SEAM_BANK) * 4 <= CTL_ZERO_BYTES, "control words inside the per-call memset");

__device__ __forceinline__ float bf2f(bf16_t v) { return __uint_as_float((unsigned)v << 16); }
__device__ __forceinline__ bf16_t f2bf(float f) { unsigned u = __float_as_uint(f); return (bf16_t)((u + 0x7fffu + ((u >> 16) & 1u)) >> 16); }
typedef float f32x2_t __attribute__((ext_vector_type(2)));
typedef __bf16 bf16x2_t __attribute__((ext_vector_type(2)));
__device__ __forceinline__ unsigned pk2(float lo, float hi) { const f32x2_t v = {lo, hi}; return __builtin_bit_cast(unsigned, __builtin_convertvector(v, bf16x2_t)); }
__device__ __forceinline__ float frcp(float x) { return __builtin_amdgcn_rcpf(x); }
__device__ __forceinline__ float fexp(float x) { return __builtin_amdgcn_exp2f(x * 1.4426950408889634f); }
__device__ __forceinline__ float sigmoidf_(float x) { return frcp(1.f + fexp(-x)); }
__host__ __device__ inline int seq_row0(int q) { return q < NB ? q * SEQ : MP + (q - NB) * DS; }
__host__ __device__ inline int seq_len(int q) { return q < NB ? SEQ : DS; }
__device__ __forceinline__ float shx(float v, int mask, int lane) { return __builtin_bit_cast(float, __builtin_amdgcn_ds_bpermute((lane ^ mask) << 2, __builtin_bit_cast(int, v))); }
__device__ __forceinline__ float sh_row15(float v, int lane) { return __builtin_bit_cast(float, __builtin_amdgcn_ds_bpermute((lane | 15) << 2, __builtin_bit_cast(int, v))); }
__device__ __forceinline__ float wave_sum(float v, int lane) {
#pragma unroll
    for (int o = 1; o < 64; o <<= 1) v += shx(v, o, lane);
    return v;
}
#ifndef BAR_SHORT
#define BAR_SHORT 1
#endif
#ifndef RES_PREFETCH
#define RES_PREFETCH 0
#endif
#ifndef SAMPLE_OUT_KSLICE
#define SAMPLE_OUT_KSLICE 1
#endif
#ifndef SAMPLE_IN_KSLICE
#define SAMPLE_IN_KSLICE 1
#endif
#ifndef CARRY_ONE_ROUND
#define CARRY_ONE_ROUND 0
#endif
#ifndef CARRY_RG_CB
#define CARRY_RG_CB 32
#endif
#ifndef CARRY_HG_CB
#define CARRY_HG_CB 32
#endif
#ifndef STATS_FUSED
#define STATS_FUSED 1
#endif
#ifndef GIN_DEPHASE
#define GIN_DEPHASE 1
#endif

namespace pg8 {
#define PG8_LAS __attribute__((address_space(3)))
typedef unsigned short bf16_t;
typedef short bf16x8 __attribute__((ext_vector_type(8)));
typedef float f32x4 __attribute__((ext_vector_type(4)));
typedef unsigned u32x4 __attribute__((ext_vector_type(4)));
constexpr int BM = 256, BK = 64, HALF = 128, HTB = HALF * BK * 2  , STAGE_BYTES = 8 * HTB, NXCD = 8, WGM = PG8_WGM;

__host__ __device__ __forceinline__ int lds_byte(int r, int c) { const int st = (r >> 4) * 2 + (c >> 5), rr = r & 15, cc = c & 31, ob = rr * 64 + cc * 2; return st * 1024 + (ob ^ (((ob >> 9) & 1) << 5)); }
__host__ __device__ __forceinline__ void stage_rc(int b, int& R, int& C) { const int st = b / 1024, sb = b % 1024, swz = sb ^ (((sb >> 9) & 1) << 5); R = (st >> 1) * 16 + swz / 64; C = (st & 1) * 32 + (swz % 64) / 2; }
__host__ __device__ __forceinline__ int perm32(int rho) { const int n = rho >> 4, i = rho & 15; return 8 * (i >> 2) + 4 * n + (i & 3); }

struct Unit { int pm, pn; };
struct Gemm { const bf16_t* A; const bf16_t* Bt; int M, N, K; };

struct StaticOrder {
    int nM, nN, nwg, G, c;
    __host__ __device__ void init(int M, int N, int G_, int c_) { nM = M / BM; nN = N / BM; nwg = nM * nN; G = G_; c = c_; }
    __host__ __device__ bool next(int i, Unit& u) const {
        const long L = (long)i * G + c; if (L >= nwg) return false;
        int wgid = (int)L; { const int q = nwg / NXCD, r = nwg % NXCD, xcd = wgid % NXCD, off = wgid / NXCD; wgid = (xcd < r ? xcd * (q + 1) : r * (q + 1) + (xcd - r) * q) + off; }
        const int nig = WGM * nN, gid = wgid / nig, fm = gid * WGM, gsz = (nM - fm) < WGM ? (nM - fm) : WGM;
        u.pm = fm + ((wgid % nig) % gsz); u.pn = (wgid % nig) / gsz; return true;
    }
    __device__ __forceinline__ void a_ready(const Unit&) const {}
    __device__ __forceinline__ void done(const Unit&) const {}
};

__device__ __forceinline__ unsigned cvt_pk_bf16(float lo, float hi) { unsigned r; asm volatile("v_cvt_pk_bf16_f32 %0, %1, %2" : "=v"(r) : "v"(lo), "v"(hi)); return r; }
typedef float f32x2 __attribute__((ext_vector_type(2)));
__device__ __forceinline__ f32x2 gelu_pk(f32x2 v) {
    const f32x2 av = __builtin_elementwise_abs(v), d = av * 0.2316418882f + 1.0f;
    f32x2 t; t.x = __builtin_amdgcn_rcpf(d.x); t.y = __builtin_amdgcn_rcpf(d.y);
    f32x2 q = t * 0.5307027145f + (-0.7265760135f); q = q * t + 0.7107068705f; q = q * t + (-0.142248368f); q = q * t + 0.127414796f; q = q * t;
    const f32x2 s = (v * v) * (-0.72134752044f);
    f32x2 e; e.x = __builtin_amdgcn_exp2f(s.x); e.y = __builtin_amdgcn_exp2f(s.y);
    const f32x2 m = v * (q * e), r = v - m;
    f32x2 o; o.x = v.x < 0.f ? m.x : r.x; o.y = v.y < 0.f ? m.y : r.y; return o;
}

template <int ACT  > struct EpiBf16 {
    static constexpr bool PERM = true, AFTER_DRAIN = false; static_assert(ACT == 0 || ACT == 1, "EpiBf16: ACT is 0 (none) or 1 (gelu_pk)");
    bf16_t* O; int ldc; const float* bias; int split_cols; size_t split_stride; float scale0;
    __device__ __forceinline__ void operator()(const f32x4 (&acc)[2][2][4][2], const Unit& u, int wr, int wc, int fr, int fq) const {
        const int row0 = u.pm * BM + wr * 64 + fr; int colt = u.pn * BM; bf16_t* base = O;
        float sc = 1.f; if (split_cols) { const int t = colt / split_cols; base += (size_t)t * split_stride; colt -= t * split_cols; if (t == 0) sc = scale0; }
        const int col0 = colt + wc * 32 + 8 * fq, bcol0 = u.pn * BM + wc * 32 + 8 * fq;
        f32x4 bv[2][2];
#pragma unroll
        for (int bj = 0; bj < 2; ++bj)
#pragma unroll
            for (int n = 0; n < 2; ++n) bv[bj][n] = bias ? *(const f32x4*)(bias + bcol0 + bj * HALF + 4 * n) : (f32x4){0.f, 0.f, 0.f, 0.f};
#pragma unroll
        for (int ai = 0; ai < 2; ++ai)
#pragma unroll
            for (int m = 0; m < 4; ++m) { bf16_t* rowp = base + (size_t)(row0 + ai * HALF + m * 16) * ldc + col0;
#pragma unroll
                for (int bj = 0; bj < 2; ++bj) { f32x4 v0 = acc[ai][bj][m][0] + bv[bj][0], v1 = acc[ai][bj][m][1] + bv[bj][1];
                    if (ACT == 1) { f32x2 a = gelu_pk((f32x2){v0[0], v0[1]}), b = gelu_pk((f32x2){v0[2], v0[3]}), c = gelu_pk((f32x2){v1[0], v1[1]}), d = gelu_pk((f32x2){v1[2], v1[3]});
                        v0 = (f32x4){a.x, a.y, b.x, b.y}; v1 = (f32x4){c.x, c.y, d.x, d.y}; }
                    v0 = v0 * sc; v1 = v1 * sc; u32x4 w; w.x = cvt_pk_bf16(v0[0], v0[1]); w.y = cvt_pk_bf16(v0[2], v0[3]); w.z = cvt_pk_bf16(v1[0], v1[1]); w.w = cvt_pk_bf16(v1[2], v1[3]);
                    *(u32x4*)(rowp + bj * HALF) = w; } }
    }
};

struct PanelStats {
    unsigned* xbuf;
    unsigned* cnt;
    unsigned* tmo;
    int ntn; float eps;
    unsigned code;
    unsigned* pub = nullptr;
    __device__ __forceinline__ bool run(const f32x4 (&v)[2][2][4][2], const Unit& u, int wr, int wc, int fr, int fq, PG8_LAS unsigned char* lds, int wid, int lane) const {
        typedef float f32x2v __attribute__((ext_vector_type(2)));
        PG8_LAS f32x2v* P = (PG8_LAS f32x2v*)lds;
        PG8_LAS f32x2v* S = (PG8_LAS f32x2v*)(lds + 8192);
        PG8_LAS unsigned* flag = (PG8_LAS unsigned*)(lds + 8192 + 2048);
#pragma unroll
        for (int ai = 0; ai < 2; ++ai)
#pragma unroll
            for (int m = 0; m < 4; ++m) {
                float s = 0.f;
#pragma unroll
                for (int bj = 0; bj < 2; ++bj)
#pragma unroll
                    for (int n = 0; n < 2; ++n) { const f32x4 x = v[ai][bj][m][n]; s += (x[0] + x[1]) + (x[2] + x[3]); }
                s += shx(s, 16, lane); s += shx(s, 32, lane);
                const float mw = s * (1.0f / 64.0f); float q = 0.f;
#pragma unroll
                for (int bj = 0; bj < 2; ++bj)
#pragma unroll
                    for (int n = 0; n < 2; ++n) { const f32x4 d = v[ai][bj][m][n] - mw; q += (d[0] * d[0] + d[1] * d[1]) + (d[2] * d[2] + d[3] * d[3]); }
                q += shx(q, 16, lane); q += shx(q, 32, lane);
                if (fq == 0) P[(ai * HALF + wr * 64 + m * 16 + fr) * 4 + wc] = (f32x2v){mw, q};
            }
        asm volatile("s_waitcnt lgkmcnt(0)" ::: "memory"); __builtin_amdgcn_s_barrier(); asm volatile("" ::: "memory");
#if STATS_FUSED
        const int row = wid * 32 + (lane & 31);
        unsigned long long* slot = (unsigned long long*)xbuf + (size_t)(u.pm * BM + row) * 4;
        if (lane < 32) {
            const f32x2v a = P[row * 4 + 0], b = P[row * 4 + 1], c = P[row * 4 + 2], d = P[row * 4 + 3];
            const float mt = (a.x + b.x + c.x + d.x) * 0.25f;
            const float da = a.x - mt, db = b.x - mt, dc = c.x - mt, dd = d.x - mt;
            const float m2 = (a.y + b.y) + (c.y + d.y) + 64.0f * ((da * da + db * db) + (dc * dc + dd * dd));
            __hip_atomic_store(slot + u.pn, ((unsigned long long)__float_as_uint(m2) << 32) | __float_as_uint(mt), __ATOMIC_RELAXED, __HIP_MEMORY_SCOPE_AGENT);
        }
        if (pub && wid == 7 && lane == 32) { __builtin_amdgcn_fence(__ATOMIC_RELEASE, "agent"); asm volatile("s_waitcnt vmcnt(0)" ::: "memory"); __hip_atomic_fetch_add(pub, 1u, __ATOMIC_RELAXED, __HIP_MEMORY_SCOPE_AGENT); }
        if (lane < 32) {
            unsigned long long w[4]; unsigned sp = 0u;
            for (;;) {
                bool all = true;
#pragma unroll
                for (int t = 0; t < 4; ++t) { w[t] = t < ntn ? __hip_atomic_load(slot + t, __ATOMIC_RELAXED, __HIP_MEMORY_SCOPE_AGENT) : 0ull; all = all && (w[t] != ~0ull); }
                if (all || ++sp > (1u << 18)) break;
                __builtin_amdgcn_s_sleep(1);
            }
            float mt[4], m2[4]; float ms = 0.f;
#pragma unroll
            for (int t = 0; t < 4; ++t) { mt[t] = t < ntn ? __uint_as_float((unsigned)w[t]) : 0.f; m2[t] = t < ntn ? __uint_as_float((unsigned)(w[t] >> 32)) : 0.f; ms += mt[t]; }
            const float mean = ms / (float)ntn; float q = 0.f;
#pragma unroll
            for (int t = 0; t < 4; ++t) if (t < ntn) { const float dm = mt[t] - mean; q += m2[t] + 256.0f * dm * dm; }
            S[row] = (f32x2v){mean, 1.0f / sqrtf(q / (256.0f * (float)ntn) + eps)};
        }
        asm volatile("s_waitcnt vmcnt(0) lgkmcnt(0)" ::: "memory"); __builtin_amdgcn_s_barrier(); asm volatile("" ::: "memory");
        (void)flag;
        return false;
#else
#if defined(BROKEN_EXCHANGE_NO_WAIT)
#warning BROKEN CONTROL BUILD: the row-statistics exchange does not wait; results are wrong by design
        if (blockIdx.x >= 64) { const long long t0_ = clock64(); while (clock64() - t0_ < 60000) __builtin_amdgcn_s_sleep(8); }
#endif
        const int row = wid * 32 + (lane & 31);
        if (lane < 32) {
            const f32x2v a = P[row * 4 + 0], b = P[row * 4 + 1], c = P[row * 4 + 2], d = P[row * 4 + 3];
            const float mt = (a.x + b.x + c.x + d.x) * 0.25f;
            const float da = a.x - mt, db = b.x - mt, dc = c.x - mt, dd = d.x - mt;
            const float m2 = (a.y + b.y) + (c.y + d.y) + 64.0f * ((da * da + db * db) + (dc * dc + dd * dd));
            unsigned long long* slot = (unsigned long long*)xbuf + ((size_t)(u.pm * BM + row) * 4 + u.pn);
            __hip_atomic_store(slot, ((unsigned long long)__float_as_uint(m2) << 32) | __float_as_uint(mt), __ATOMIC_RELAXED, __HIP_MEMORY_SCOPE_AGENT);
        }
        asm volatile("s_waitcnt vmcnt(0)" ::: "memory");
        if (lane == 0) __hip_atomic_fetch_add(cnt + 64 * u.pm, 1u, __ATOMIC_RELAXED, __HIP_MEMORY_SCOPE_AGENT);
        if (pub && wid == 7 && lane == 0) { __builtin_amdgcn_fence(__ATOMIC_RELEASE, "agent"); asm volatile("s_waitcnt vmcnt(0)" ::: "memory"); __hip_atomic_fetch_add(pub, 1u, __ATOMIC_RELAXED, __HIP_MEMORY_SCOPE_AGENT); }
        if (wid == 0) {
            bool dead = false; const unsigned long long t0 = __builtin_amdgcn_s_memrealtime(); const unsigned want = 8u * (unsigned)ntn;
            for (;;) {
#if defined(BROKEN_EXCHANGE_NO_WAIT)
                break;
#endif
                if ((unsigned)__builtin_amdgcn_readfirstlane(__hip_atomic_load(cnt + 64 * u.pm, __ATOMIC_RELAXED, __HIP_MEMORY_SCOPE_AGENT)) >= want) break;
                if (__builtin_amdgcn_s_memrealtime() - t0 > 2000000ull) {
                    if (lane == 0) { unsigned expect = 0u; __hip_atomic_compare_exchange_strong(tmo + 1, &expect, code | (unsigned)(u.pm & 0xff), __ATOMIC_RELAXED, __ATOMIC_RELAXED, __HIP_MEMORY_SCOPE_AGENT);
                                     __hip_atomic_store(tmo, 1u, __ATOMIC_RELAXED, __HIP_MEMORY_SCOPE_AGENT); }
                    dead = true; break; }
                __builtin_amdgcn_s_sleep(2);
            }
            __builtin_amdgcn_fence(__ATOMIC_ACQUIRE, "agent");
            if (lane == 0) flag[0] = dead ? 1u : 0u;
        }
        asm volatile("s_waitcnt vmcnt(0) lgkmcnt(0)" ::: "memory"); __builtin_amdgcn_s_barrier(); asm volatile("" ::: "memory");
        const bool bad = flag[0] != 0u;
        if (lane < 32) {
            const unsigned long long* slot = (const unsigned long long*)xbuf + (size_t)(u.pm * BM + row) * 4; float mt[4], m2[4]; float ms = 0.f;
#pragma unroll
            for (int t = 0; t < 4; ++t) { if (t < ntn) { const unsigned long long w = __hip_atomic_load(slot + t, __ATOMIC_RELAXED, __HIP_MEMORY_SCOPE_AGENT); mt[t] = __uint_as_float((unsigned)w); m2[t] = __uint_as_float((unsigned)(w >> 32)); } else { mt[t] = 0.f; m2[t] = 0.f; } ms += mt[t]; }
            const float mean = ms / (float)ntn; float q = 0.f;
#pragma unroll
            for (int t = 0; t < 4; ++t) if (t < ntn) { const float dm = mt[t] - mean; q += m2[t] + 256.0f * dm * dm; }
            S[row] = (f32x2v){mean, 1.0f / sqrtf(q / (256.0f * (float)ntn) + eps)};
        }
        asm volatile("s_waitcnt lgkmcnt(0)" ::: "memory"); __builtin_amdgcn_s_barrier(); asm volatile("" ::: "memory");
        return bad;
#endif
    }
};
#if defined(PROBE_TIME) && PROBE_TIME >= 0
#define EPI_STAMP(k_) do { asm volatile("s_waitcnt vmcnt(0) lgkmcnt(0)" ::: "memory"); __builtin_amdgcn_sched_barrier(0); if (blockIdx.x == 0 && threadIdx.x == 0) { const unsigned long long t_ = __builtin_amdgcn_s_memrealtime(); \
        volatile PG8_LAS unsigned* ms_ = (volatile PG8_LAS unsigned*)(lds + 135168 + 512); ms_[2 * (k_)] = (unsigned)t_; ms_[1 + 2 * (k_)] = (unsigned)(t_ >> 32); } __builtin_amdgcn_sched_barrier(0); } while (0)
#else
#define EPI_STAMP(k_) do { } while (0)
#endif
struct EpiDeepNorm {
    static constexpr bool PERM = false, AFTER_DRAIN = true;
    const float* base; const bf16_t* base16; float* out; bf16_t* xn; int ldc; const float* gamma; const float* beta; float alpha; PanelStats st;
    __device__ __forceinline__ void fused(f32x4 (&acc)[2][2][4][2], const Unit& u, int wr, int wc, int fr, int fq, PG8_LAS unsigned char* lds, int wid, int lane) const {
        typedef float f32x2v __attribute__((ext_vector_type(2))); typedef unsigned u32x2v __attribute__((ext_vector_type(2)));
        const PG8_LAS f32x2v* S = (const PG8_LAS f32x2v*)(lds + 8192);
        const int col0 = u.pn * BM + wc * 32 + 4 * fq;
        const int sb_ = out ? 16 : 12; (void)sb_;
        EPI_STAMP(sb_);
        if (base16) {
            u32x2v rw[2][4][2][2];
#pragma unroll
            for (int ai = 0; ai < 2; ++ai)
#pragma unroll
                for (int m = 0; m < 4; ++m) { const int r = ai * HALF + wr * 64 + m * 16 + fr; const size_t off = (size_t)(u.pm * BM + r) * ldc + col0;
#pragma unroll
                    for (int bj = 0; bj < 2; ++bj)
#pragma unroll
                        for (int n = 0; n < 2; ++n) rw[ai][m][bj][n] = *(const u32x2v*)(base16 + off + bj * HALF + n * 16); }
#pragma unroll
            for (int ai = 0; ai < 2; ++ai)
#pragma unroll
                for (int m = 0; m < 4; ++m)
#pragma unroll
                    for (int bj = 0; bj < 2; ++bj)
#pragma unroll
                        for (int n = 0; n < 2; ++n) { const u32x2v w = rw[ai][m][bj][n];
                            const f32x4 bs = (f32x4){__uint_as_float(w.x << 16), __uint_as_float(w.x & 0xffff0000u), __uint_as_float(w.y << 16), __uint_as_float(w.y & 0xffff0000u)};
                            acc[ai][bj][m][n] = acc[ai][bj][m][n] + bs * alpha; }
        } else {
#pragma unroll
        for (int ai = 0; ai < 2; ++ai)
#pragma unroll
            for (int m = 0; m < 4; ++m) { const int r = ai * HALF + wr * 64 + m * 16 + fr; const size_t off = (size_t)(u.pm * BM + r) * ldc + col0;
#pragma unroll
                for (int bj = 0; bj < 2; ++bj)
#pragma unroll
                    for (int n = 0; n < 2; ++n) { const f32x4 bs = *(const f32x4*)(base + off + bj * HALF + n * 16); acc[ai][bj][m][n] = acc[ai][bj][m][n] + bs * alpha; }
                asm volatile("" : "+v"(acc[ai][0][m][0]), "+v"(acc[ai][0][m][1]), "+v"(acc[ai][1][m][0]), "+v"(acc[ai][1][m][1]));
                if (m & 1) asm volatile("" ::: "memory"); }
        }
        EPI_STAMP(sb_ + 1);
        (void)st.run(acc, u, wr, wc, fr, fq, lds, wid, lane);
        EPI_STAMP(sb_ + 2);
        f32x4 gv[2][2], bv[2][2];
#pragma unroll
        for (int bj = 0; bj < 2; ++bj)
#pragma unroll
            for (int n = 0; n < 2; ++n) { gv[bj][n] = *(const f32x4*)(gamma + col0 + bj * HALF + n * 16); bv[bj][n] = *(const f32x4*)(beta + col0 + bj * HALF + n * 16); }
#pragma unroll
        for (int ai = 0; ai < 2; ++ai)
#pragma unroll
            for (int m = 0; m < 4; ++m) { const int r = ai * HALF + wr * 64 + m * 16 + fr; const f32x2v sr = S[r]; const size_t off = (size_t)(u.pm * BM + r) * ldc + col0;
#pragma unroll
                for (int bj = 0; bj < 2; ++bj)
#pragma unroll
                    for (int n = 0; n < 2; ++n) { const f32x4 o = (acc[ai][bj][m][n] - sr.x) * sr.y * gv[bj][n] + bv[bj][n];
                        if (out) *(f32x4*)(out + off + bj * HALF + n * 16) = o;
                        if (xn) { u32x2v w; w.x = cvt_pk_bf16(o[0], o[1]); w.y = cvt_pk_bf16(o[2], o[3]); *(u32x2v*)(xn + off + bj * HALF + n * 16) = w; } }
                asm volatile("" ::: "memory"); }
        EPI_STAMP(sb_ + 3);
    }
};

__device__ __forceinline__ int pg8_tid();
template <class Epi, class Sched, bool ALIGN_EPI = false, bool SP2 = false>
__device__ __forceinline__ void gemm_phase(PG8_LAS unsigned char* lds, const Gemm g, const Sched& S, const Epi& E) {
    const int tid = pg8_tid(), wid = __builtin_amdgcn_readfirstlane(tid >> 6), lane = tid & 63, wr = wid >> 2, wc = wid & 3, fr = lane & 15, fq = lane >> 4;
    const int K = g.K, nt = K / BK;
    unsigned voffA[2], voffB[2];
#pragma unroll
    for (int i = 0; i < 2; ++i) { int R, C; stage_rc(tid * 16 + i * 8192, R, C); const int Rb = Epi::PERM ? ((R & ~31) + perm32(R & 31)) : R;
        voffA[i] = (unsigned)(R * K + C) * 2u; voffB[i] = (unsigned)(Rb * K + C) * 2u; }
    const size_t kstep = (size_t)(BK * 2);
    const size_t hstep = (size_t)HALF * K * 2;
    const size_t tstep = 2 * hstep;
    const unsigned ldsw = (unsigned)wid * 1024u;
    const int aoff = lds_byte(wr * 64 + fr, fq * 8), boff = lds_byte(wc * 32 + fr, fq * 8);
#define PG8_SA(b, h) (((b) * 2 + (h)) * HTB)
#define PG8_SB(b, h) ((4 + (b) * 2 + (h)) * HTB)
#define PG8_STAGE(bufoff, gbase, voff) do { _Pragma("unroll") for (int _i = 0; _i < 2; ++_i) \
        __builtin_amdgcn_global_load_lds((const unsigned*)((const char*)(gbase) + (voff)[_i]), (PG8_LAS unsigned*)(lds + (bufoff) + ldsw + _i * 8192), 16, 0, 0); } while (0)
#define PG8_LDA(dst, b, h) do { _Pragma("unroll") for (int m = 0; m < 4; ++m) _Pragma("unroll") for (int k = 0; k < 2; ++k) dst[m][k] = *(const PG8_LAS bf16x8*)(lds + PG8_SA(b, h) + aoff + m * 2048 + k * 1024); } while (0)
#define PG8_LDB(dst, b, h) do { _Pragma("unroll") for (int n = 0; n < 2; ++n) _Pragma("unroll") for (int k = 0; k < 2; ++k) dst[n][k] = *(const PG8_LAS bf16x8*)(lds + PG8_SB(b, h) + boff + n * 2048 + k * 1024); } while (0)
#define PG8_MMA(ai, bj, At, Bt) do { __builtin_amdgcn_s_setprio(1); _Pragma("unroll") for (int m = 0; m < 4; ++m) _Pragma("unroll") for (int n = 0; n < 2; ++n) _Pragma("unroll") for (int k = 0; k < 2; ++k) \
        acc[ai][bj][m][n] = __builtin_amdgcn_mfma_f32_16x16x32_bf16(Bt[n][k], At[m][k], acc[ai][bj][m][n], 0, 0, 0); __builtin_amdgcn_s_setprio(0); } while (0)
#define PG8_WAIT_V(n) asm volatile("s_waitcnt vmcnt(" #n ")" ::: "memory")
#define PG8_WAIT_L(n) asm volatile("s_waitcnt lgkmcnt(" #n ")" ::: "memory")
#define PG8_BAR __builtin_amdgcn_s_barrier()
#define PG8_SCHED __builtin_amdgcn_sched_barrier(0)
    Unit cur, nxt; int ui = 0;
    if (!S.next(0, cur)) return;
    f32x4 acc[2][2][4][2];
#pragma unroll
    for (int a = 0; a < 2; ++a)
#pragma unroll
        for (int b = 0; b < 2; ++b)
#pragma unroll
            for (int m = 0; m < 4; ++m)
#pragma unroll
                for (int n = 0; n < 2; ++n) acc[a][b][m][n] = (f32x4){0.f, 0.f, 0.f, 0.f};
    bf16x8 At[4][2], B0[2][2], B1[2][2];
    const char* cA = (const char*)g.A + (size_t)cur.pm * tstep; const char* cB = (const char*)g.Bt + (size_t)cur.pn * tstep;
    S.a_ready(cur);
    if constexpr (SP2) {
        PG8_STAGE(PG8_SB(0, 0), cB, voffB); PG8_STAGE(PG8_SB(0, 1), cB + hstep, voffB); PG8_STAGE(PG8_SA(0, 0), cA, voffA); PG8_STAGE(PG8_SA(0, 1), cA + hstep, voffA);
        if (wr == 1) PG8_BAR;
        PG8_WAIT_V(2); PG8_BAR;
        PG8_STAGE(PG8_SB(1, 0), cB + kstep, voffB); PG8_STAGE(PG8_SA(1, 0), cA + kstep, voffA); PG8_STAGE(PG8_SB(1, 1), cB + hstep + kstep, voffB);
        PG8_WAIT_V(6); PG8_BAR;
    } else {
        PG8_STAGE(PG8_SB(0, 0), cB, voffB); PG8_STAGE(PG8_SA(0, 0), cA, voffA); PG8_STAGE(PG8_SB(0, 1), cB + hstep, voffB); PG8_STAGE(PG8_SA(0, 1), cA + hstep, voffA);
        if (wr == 1) PG8_BAR;
        PG8_WAIT_V(4); PG8_BAR;
        PG8_STAGE(PG8_SB(1, 0), cB + kstep, voffB); PG8_STAGE(PG8_SA(1, 0), cA + kstep, voffA); PG8_STAGE(PG8_SB(1, 1), cB + hstep + kstep, voffB);
        PG8_WAIT_V(6); PG8_BAR;
    }
    for (;;) {
        const bool has_next = S.next(ui + 1, nxt);
        const char* nA = has_next ? (const char*)g.A + (size_t)nxt.pm * tstep : cA; const char* nB = has_next ? (const char*)g.Bt + (size_t)nxt.pn * tstep : cB;
        for (int t = 0; t < nt; t += 2) {
            const bool last = (t == nt - 2);
            const char* a1 = cA + (size_t)(t + 1) * kstep;
            const char* a2 = last ? nA : cA + (size_t)(t + 2) * kstep; const char* b2 = last ? nB : cB + (size_t)(t + 2) * kstep;
            const char* a3 = a2 + kstep; const char* b3 = b2 + kstep;
            if (last && has_next) S.a_ready(nxt);
            if constexpr (SP2) {
            PG8_LDB(B0, 0, 0); PG8_LDB(B1, 0, 1); PG8_SCHED; PG8_LDA(At, 0, 0); PG8_STAGE(PG8_SA(1, 1), a1 + hstep, voffA);
            PG8_WAIT_V(8); PG8_WAIT_L(0); PG8_BAR; PG8_MMA(0, 0, At, B0); PG8_MMA(0, 1, At, B1); PG8_BAR; PG8_SCHED;
            PG8_LDA(At, 0, 1); PG8_STAGE(PG8_SB(0, 0), b2, voffB); PG8_STAGE(PG8_SB(0, 1), b2 + hstep, voffB); PG8_STAGE(PG8_SA(0, 0), a2, voffA);
            PG8_WAIT_V(8); PG8_WAIT_L(0); PG8_BAR; PG8_MMA(1, 0, At, B0); PG8_MMA(1, 1, At, B1); PG8_BAR; PG8_SCHED;
            PG8_LDB(B0, 1, 0); PG8_LDB(B1, 1, 1); PG8_SCHED; PG8_LDA(At, 1, 0); PG8_STAGE(PG8_SA(0, 1), a2 + hstep, voffA);
            PG8_WAIT_V(8); PG8_WAIT_L(0); PG8_BAR; PG8_MMA(0, 0, At, B0); PG8_MMA(0, 1, At, B1); PG8_BAR; PG8_SCHED;
            PG8_LDA(At, 1, 1); PG8_STAGE(PG8_SB(1, 0), b3, voffB); PG8_STAGE(PG8_SB(1, 1), b3 + hstep, voffB); PG8_STAGE(PG8_SA(1, 0), a3, voffA);
            PG8_WAIT_V(8); PG8_WAIT_L(0); PG8_BAR; PG8_MMA(1, 0, At, B0); PG8_MMA(1, 1, At, B1); PG8_BAR; PG8_SCHED;
            } else {
            PG8_LDB(B0, 0, 0); PG8_SCHED; PG8_LDA(At, 0, 0); PG8_STAGE(PG8_SA(1, 1), a1 + hstep, voffA);
            PG8_WAIT_L(8); PG8_BAR; PG8_WAIT_L(0); PG8_MMA(0, 0, At, B0); PG8_BAR; PG8_SCHED;
            PG8_LDB(B1, 0, 1); PG8_STAGE(PG8_SB(0, 0), b2, voffB);
            PG8_BAR; PG8_WAIT_L(0); PG8_MMA(0, 1, At, B1); PG8_BAR;
            PG8_LDA(At, 0, 1); PG8_STAGE(PG8_SA(0, 0), a2, voffA);
            PG8_BAR; PG8_WAIT_L(0); PG8_MMA(1, 0, At, B0); PG8_BAR; PG8_SCHED;
            PG8_STAGE(PG8_SB(0, 1), b2 + hstep, voffB);
            PG8_WAIT_V(6); PG8_BAR; PG8_MMA(1, 1, At, B1); PG8_BAR;
            PG8_LDB(B0, 1, 0); PG8_SCHED; PG8_LDA(At, 1, 0); PG8_STAGE(PG8_SA(0, 1), a2 + hstep, voffA);
            PG8_WAIT_L(8); PG8_BAR; PG8_WAIT_L(0); PG8_MMA(0, 0, At, B0); PG8_BAR; PG8_SCHED;
            PG8_LDB(B1, 1, 1); PG8_STAGE(PG8_SB(1, 0), b3, voffB);
            PG8_BAR; PG8_WAIT_L(0); PG8_MMA(0, 1, At, B1); PG8_BAR;
            PG8_LDA(At, 1, 1); PG8_STAGE(PG8_SA(1, 0), a3, voffA);
            PG8_BAR; PG8_WAIT_L(0); PG8_MMA(1, 0, At, B0); PG8_BAR; PG8_SCHED;
            PG8_STAGE(PG8_SB(1, 1), b3 + hstep, voffB);
            PG8_WAIT_V(6); PG8_BAR; PG8_MMA(1, 1, At, B1); PG8_BAR;
            }
        }
        if constexpr (ALIGN_EPI) { if (wr == 0) PG8_BAR; }
        if constexpr (!Epi::AFTER_DRAIN) { E(acc, cur, wr, wc, fr, fq); S.done(cur); }
        if (!has_next) break;
#pragma unroll
        for (int a = 0; a < 2; ++a)
#pragma unroll
            for (int b = 0; b < 2; ++b)
#pragma unroll
                for (int m = 0; m < 4; ++m)
#pragma unroll
                    for (int n = 0; n < 2; ++n) acc[a][b][m][n] = (f32x4){0.f, 0.f, 0.f, 0.f};
        cur = nxt; cA = nA; cB = nB; ++ui;
        if constexpr (ALIGN_EPI) { if (wr == 1) PG8_BAR; }
    }
    PG8_WAIT_V(0);
    if constexpr (!ALIGN_EPI) { if (wr == 0) PG8_BAR; }
    PG8_BAR;
    if constexpr (Epi::AFTER_DRAIN) { E.fused(acc, cur, wr, wc, fr, fq, lds, wid, lane); S.done(cur); }
#undef PG8_SA
#undef PG8_SB
#undef PG8_STAGE
#undef PG8_LDA
#undef PG8_LDB
#undef PG8_MMA
#undef PG8_WAIT_V
#undef PG8_WAIT_L
#undef PG8_BAR
#undef PG8_SCHED
}
}

#ifndef PG8_SP2
#define PG8_SP2 true
#endif
#define LAS __attribute__((address_space(3)))
#define GAS __attribute__((address_space(1)))
typedef unsigned v4u __attribute__((ext_vector_type(4)));
typedef float f32x4 __attribute__((ext_vector_type(4)));
typedef short bf16x8 __attribute__((ext_vector_type(8)));
#define MFMA16(a, b, c) __builtin_amdgcn_mfma_f32_16x16x32_bf16((a), (b), (c), 0, 0, 0)
#define LDS_WAIT() asm volatile("s_waitcnt lgkmcnt(0)" ::: "memory")
#define VM_WAIT() asm volatile("s_waitcnt vmcnt(0)" ::: "memory")

constexpr int NWAVES = 8, NTHREADS = NWAVES * 64;
constexpr int RING_BYTES = 131072, MISC_OFF = 135168, LDS_BYTES = 147456;

__device__ __forceinline__ unsigned hw_wave_slot() { return (unsigned)__builtin_amdgcn_s_getreg((5 << 11) | 4) & 63u; }
__device__ __forceinline__ void park_wave_index() {
    extern __shared__ __attribute__((aligned(16))) unsigned char lds_park[];
    if ((threadIdx.x & 63) == 0) ((LAS unsigned*)((LAS unsigned char*)lds_park + MISC_OFF + 256))[hw_wave_slot()] = threadIdx.x >> 6;
}
__device__ __forceinline__ int fresh_tid() {
    extern __shared__ __attribute__((aligned(16))) unsigned char lds_park[];
    const unsigned w = __builtin_amdgcn_readfirstlane(((volatile LAS unsigned*)((LAS unsigned char*)lds_park + MISC_OFF + 256))[hw_wave_slot()]);
    unsigned l; asm volatile("v_mbcnt_lo_u32_b32 %0, -1, 0\n\tv_mbcnt_hi_u32_b32 %0, -1, %0" : "=v"(l));
    return (int)((w << 6) | l);
}
#define XB_TMO      128
#define XB_XCNT(j)  (256  + 64 * (j))
#define XB_XSUB(j)  (1280 + 64 * (j))
#define XB_XGEN(j)  (2304 + 64 * (j))
#define XB_TOP      3328
#define XB_TOPGEN   3392
#define XCD_BAR_WORDS 3456
#define XB_SPIN_CAP (1u << 18)
__device__ __forceinline__ unsigned xb_ld(unsigned* p)              { return __hip_atomic_load(p, __ATOMIC_RELAXED, __HIP_MEMORY_SCOPE_AGENT); }
__device__ __forceinline__ unsigned xb_add(unsigned* p, unsigned v) { return __hip_atomic_fetch_add(p, v, __ATOMIC_RELAXED, __HIP_MEMORY_SCOPE_AGENT); }
__device__ __forceinline__ unsigned xb_xcc_id() { return (unsigned)__builtin_amdgcn_s_getreg((3 << 11) | 20) & 0xFu; }
#define XB_SPIN(cond, bar) do { unsigned _sp = 0; while (cond) { __builtin_amdgcn_s_sleep(1); \
    if ((++_sp & 255u) == 0u) { if (xb_ld(&(bar)[XB_TMO])) break; if (_sp > XB_SPIN_CAP) { atomicAdd(&(bar)[XB_TMO], 1u); break; } } } } while (0)
struct XcdBarrier { unsigned* bar; unsigned x; volatile LAS unsigned* st; };
__device__ __forceinline__ XcdBarrier xcd_barrier_post(unsigned* bar, volatile LAS unsigned* st) {
    XcdBarrier b; b.bar = bar; b.x = xb_xcc_id(); b.st = st;
    if (threadIdx.x == 0) (void)xb_add(&bar[XB_XCNT(b.x)], 1u);
    return b;
}
__device__ __forceinline__ void xcd_barrier_complete(unsigned* bar, unsigned x, unsigned& nloc, unsigned& nx) {
    const unsigned G = gridDim.x * gridDim.y * gridDim.z;
    unsigned sum, cnt, mine, sp = 0u;
    for (;;) {
        sum = 0u; cnt = 0u; mine = 0u;
#pragma unroll
        for (unsigned j = 0; j < 16; ++j) { const unsigned c = xb_ld(&bar[XB_XCNT(j)]); sum += c; cnt += (c > 0u) ? 1u : 0u; mine = (j == x) ? c : mine; }
        if (sum == G) break;
        __builtin_amdgcn_s_sleep(1);
        if ((++sp & 255u) == 0u) { if (xb_ld(&bar[XB_TMO])) break; if (sp > XB_SPIN_CAP) { atomicAdd(&bar[XB_TMO], 1u); break; } }
    }
    nloc = mine > 0u ? mine : 1u; nx = cnt > 0u ? cnt : 1u;
}
__device__ __forceinline__ void xcd_barrier_impl(const XcdBarrier& b) {
    asm volatile("s_waitcnt vmcnt(0)" ::: "memory");
    __syncthreads();
    if (fresh_tid() == 0) {
        unsigned* bar = b.bar;
        __builtin_amdgcn_s_waitcnt(0);
        unsigned nloc = b.st[0], nx = b.st[1];
        if (nloc == 0u) { xcd_barrier_complete(bar, b.x, nloc, nx); b.st[0] = nloc; b.st[1] = nx; }
        const unsigned old = xb_add(&bar[XB_XSUB(b.x)], 1u);
        const unsigned gen = old / nloc;
#if BAR_SHORT
        if (old + 1u == (gen + 1u) * nloc) {
            __builtin_amdgcn_fence(__ATOMIC_RELEASE, "agent");
            asm volatile("s_waitcnt vmcnt(0)" ::: "memory");
            (void)xb_add(&bar[XB_TOP], 1u);
        }
        { const unsigned want = (gen + 1u) * nx; XB_SPIN(xb_ld(&bar[XB_TOP]) < want, bar); }
        __builtin_amdgcn_fence(__ATOMIC_ACQUIRE, "agent");
        asm volatile("s_waitcnt vmcnt(0)" ::: "memory");
#else
        if (old + 1u == (gen + 1u) * nloc) {
            __builtin_amdgcn_fence(__ATOMIC_RELEASE, "agent");
            asm volatile("s_waitcnt vmcnt(0)" ::: "memory");
            const unsigned og = xb_add(&bar[XB_TOP], 1u);
            const unsigned tg = og / nx;
            if (og + 1u == (tg + 1u) * nx) xb_add(&bar[XB_TOPGEN], 1u);
            else XB_SPIN(xb_ld(&bar[XB_TOPGEN]) == tg, bar);
            __builtin_amdgcn_fence(__ATOMIC_ACQUIRE, "agent");
            xb_add(&bar[XB_XGEN(b.x)], 1u);
            asm volatile("s_waitcnt vmcnt(0)" ::: "memory");
        } else {
            XB_SPIN(xb_ld(&bar[XB_XGEN(b.x)]) == gen, bar);
            __builtin_amdgcn_fence(__ATOMIC_ACQUIRE, "agent");
            asm volatile("s_waitcnt vmcnt(0)" ::: "memory");
        }
#endif
    }
    __syncthreads();
}

struct Args { const float* in[21]; float* out; unsigned char* ws; int phase; int layer; };
__device__ __forceinline__ void grid_barrier(const Args& a, LAS unsigned char* lds) {
    XcdBarrier b; b.bar = (unsigned*)(a.ws + WS_CTL) + CW_BAR; b.x = xb_xcc_id(); b.st = (volatile LAS unsigned*)(lds + MISC_OFF) + 8;
    xcd_barrier_impl(b);
}
namespace pg8 { __device__ __forceinline__ int pg8_tid() { return fresh_tid(); } }
__device__ __forceinline__ int fresh_bid() { int b = blockIdx.x; asm volatile("" : "+s"(b)); return b; }

__device__ __forceinline__ void p0_transpose_item(const float* W, int K, int N, bf16_t* WT, LAS float* scr, int item, int lane) {
    const int nblk = N / 32, kb = item / nblk, nb = item % nblk, k0 = 64 * kb, n0 = 32 * nb;
    float wv[32];
#pragma unroll
    for (int i = 0; i < 32; ++i) { const int kk = 2 * i + (lane >> 5); wv[i] = W[(size_t)(k0 + kk) * N + n0 + (lane & 31)]; }
#pragma unroll
    for (int i = 0; i < 32; ++i) { const int kk = 2 * i + (lane >> 5); scr[kk * 33 + (lane & 31)] = wv[i]; }
    LDS_WAIT(); asm volatile("" ::: "memory");
    const int c = lane & 7;
#pragma unroll
    for (int j = 0; j < 4; ++j) { const int n = (lane >> 3) + 8 * j; const LAS float* s = scr + (8 * c) * 33 + n;
        v4u o; o.x = pk2(s[0 * 33], s[1 * 33]); o.y = pk2(s[2 * 33], s[3 * 33]); o.z = pk2(s[4 * 33], s[5 * 33]); o.w = pk2(s[6 * 33], s[7 * 33]);
        *(v4u*)(WT + (size_t)(n0 + n) * K + k0 + 8 * c) = o; }
    LDS_WAIT(); asm volatile("" ::: "memory");
}

__device__ __forceinline__ void phase_prologue(const Args& a, LAS unsigned char* lds) {
    const int tid = fresh_tid(), bid = fresh_bid(), lane = tid & 63, wave = __builtin_amdgcn_readfirstlane(tid >> 6);
    const int gw = bid * NWAVES + wave, NGW = gridDim.x * NWAVES;
    LAS float* scr = (LAS float*)(lds + wave * 16384);
    constexpr int I_IN = (D / 64) * (DIN / 32), I_OUT = (D / 64) * (D / 32), NITEMS = 2 * (I_IN + I_OUT);
    for (int it = gw; it < NITEMS; it += NGW) {
        int r = it;
        if (r < 2 * I_IN) { const int l = r / I_IN; p0_transpose_item(a.in[6] + (size_t)l * D * DIN, D, DIN, (bf16_t*)(a.ws + WS_WIN) + (size_t)l * DIN * D, scr, r % I_IN, lane); continue; }
        r -= 2 * I_IN;
        { const int l = r / I_OUT; p0_transpose_item(a.in[18] + (size_t)l * D * D, D, D, (bf16_t*)(a.ws + WS_WOUT) + (size_t)l * D * D, scr, r % I_OUT, lane); }
    }
    const size_t n8 = (size_t)M * D / 8, NT = (size_t)gridDim.x * NTHREADS;
    for (size_t i0 = (size_t)bid * NTHREADS + tid; i0 < n8; i0 += 4 * NT) {
        f32x4 v0[4], v1[4];
#pragma unroll
        for (int u = 0; u < 4; ++u) { const size_t i = i0 + u * NT; const size_t e = (i < n8 ? i : i0) * 8;
            const float* src = e < (size_t)MP * D ? a.in[0] + e : a.in[1] + (e - (size_t)MP * D);
            v0[u] = *(const f32x4*)src; v1[u] = *(const f32x4*)(src + 4); }
#pragma unroll
        for (int u = 0; u < 4; ++u) { const size_t i = i0 + u * NT; if (i < n8) { const size_t e = i * 8;
            v4u o; o.x = pk2(v0[u][0], v0[u][1]); o.y = pk2(v0[u][2], v0[u][3]); o.z = pk2(v1[u][0], v1[u][1]); o.w = pk2(v1[u][2], v1[u][3]);
            *(v4u*)((bf16_t*)(a.ws + WS_XN) + e) = o; } }
    }
}

constexpr int SG_PITCH = 2064;
static_assert(64 * SG_PITCH <= MISC_OFF, "small GEMM A tile fits below the LDS control words");
__device__ __forceinline__ void sg_stage_bf16(LAS unsigned char* lds, const bf16_t* A, int tid) {
#pragma unroll
    for (int it = 0; it < 16; ++it) { const int p = it * NTHREADS + tid, r = p >> 7, c16 = p & 127;
        *(LAS v4u*)(lds + r * SG_PITCH + c16 * 16) = *(const v4u*)(A + (size_t)r * D + c16 * 8); }
}
__device__ __forceinline__ void sg_stage_ln(LAS unsigned char* lds, const float* Y, const float* gamma, const float* beta, float* x1, int wave, int lane) {
    f32x4 gv[4], bv[4];
#pragma unroll
    for (int j = 0; j < 4; ++j) { gv[j] = *(const f32x4*)(gamma + 4 * lane + 256 * j); bv[j] = *(const f32x4*)(beta + 4 * lane + 256 * j); }
#pragma unroll 2
    for (int rr = 0; rr < 8; ++rr) {
        const int r = wave * 8 + rr;
        f32x4 v[4]; float s = 0.f;
#pragma unroll
        for (int j = 0; j < 4; ++j) { v[j] = *(const f32x4*)(Y + (size_t)r * D + 4 * lane + 256 * j); s += (v[j][0] + v[j][1]) + (v[j][2] + v[j][3]); }
        const float mean = wave_sum(s, lane) * (1.f / D); float s2 = 0.f;
#pragma unroll
        for (int j = 0; j < 4; ++j) { v[j] = v[j] - mean; s2 += (v[j][0] * v[j][0] + v[j][1] * v[j][1]) + (v[j][2] * v[j][2] + v[j][3] * v[j][3]); }
        const float rstd = rsqrtf(wave_sum(s2, lane) * (1.f / D) + LN_EPS);
#pragma unroll
        for (int j = 0; j < 4; ++j) { const f32x4 o = v[j] * rstd * gv[j] + bv[j];
            if (x1) *(f32x4*)(x1 + (size_t)r * D + 4 * lane + 256 * j) = o;
            typedef unsigned u2 __attribute__((ext_vector_type(2))); u2 w; w.x = pk2(o[0], o[1]); w.y = pk2(o[2], o[3]);
            *(LAS u2*)(lds + r * SG_PITCH + (4 * lane + 256 * j) * 2) = w; }
    }
}
struct SgB { bf16x8 f[16][2]; };
__device__ __forceinline__ void sg_loadB(SgB& B, const bf16_t* Bt, int col0, int wave, int lane) {
    const int fq = lane >> 4, lr = lane & 15, kh = wave >> 2, wc = wave & 3;
    const bf16_t* b0 = Bt + (size_t)(col0 + 32 * wc + lr) * D + 512 * kh + 8 * fq;
#pragma unroll
    for (int k = 0; k < 16; ++k) { B.f[k][0] = *(const bf16x8*)(b0 + 32 * k); B.f[k][1] = *(const bf16x8*)(b0 + (size_t)16 * D + 32 * k); }
}
__device__ __forceinline__ bool sg_mma_reduce(LAS unsigned char* lds, const SgB& B, int wave, int lane, f32x4 (&acc)[2][4]) {
    const int fq = lane >> 4, lr = lane & 15, kh = wave >> 2, wc = wave & 3;
#pragma unroll
    for (int i = 0; i < 2; ++i)
#pragma unroll
        for (int j = 0; j < 4; ++j) acc[i][j] = (f32x4){0.f, 0.f, 0.f, 0.f};
    LAS const unsigned char* a0 = lds + lr * SG_PITCH + 1024 * kh + 16 * fq;
#pragma unroll
    for (int k = 0; k < 16; ++k) {
#pragma unroll
        for (int jt = 0; jt < 4; ++jt) { const bf16x8 af = *(LAS const bf16x8*)(a0 + 16 * jt * SG_PITCH + 64 * k);
            acc[0][jt] = MFMA16(B.f[k][0], af, acc[0][jt]); acc[1][jt] = MFMA16(B.f[k][1], af, acc[1][jt]); }
    }
    __syncthreads();
    LAS f32x4* xb = (LAS f32x4*)lds + (size_t)wc * 512 + lane;
    if (kh == 1) {
#pragma unroll
        for (int i = 0; i < 2; ++i)
#pragma unroll
            for (int j = 0; j < 4; ++j) xb[(i * 4 + j) * 64] = acc[i][j];
    }
    __syncthreads();
    if (kh == 0) {
#pragma unroll
        for (int i = 0; i < 2; ++i)
#pragma unroll
            for (int j = 0; j < 4; ++j) acc[i][j] = acc[i][j] + xb[(i * 4 + j) * 64];
    }
    return kh == 0;
}
__device__ __forceinline__ void sample_in_tile(const Args& a, LAS unsigned char* lds, int layer, int it) {
    const int tid = fresh_tid(), lane = tid & 63, wave = __builtin_amdgcn_readfirstlane(tid >> 6);
    const int rt = it / 24, ct = it % 24;
    SgB B; sg_loadB(B, (const bf16_t*)(a.ws + WS_WIN) + (size_t)layer * DIN * D, ct * 128, wave, lane);
    sg_stage_bf16(lds, (const bf16_t*)(a.ws + WS_XN) + (size_t)(MP + 64 * rt) * D, tid);
    __syncthreads();
    f32x4 acc[2][4];
    if (sg_mma_reduce(lds, B, wave, lane, acc)) {
        const int fq = lane >> 4, lr = lane & 15, wc = wave & 3;
        bf16_t* proj = (bf16_t*)(a.ws + WS_PROJ) + (size_t)(MP + 64 * rt + lr) * DIN + ct * 128 + 32 * wc + 4 * fq;
#pragma unroll
        for (int jn = 0; jn < 2; ++jn)
#pragma unroll
            for (int jt = 0; jt < 4; ++jt) { typedef unsigned u2 __attribute__((ext_vector_type(2))); u2 w; w.x = pk2(acc[jn][jt][0], acc[jn][jt][1]); w.y = pk2(acc[jn][jt][2], acc[jn][jt][3]);
                *(u2*)(proj + (size_t)(16 * jt) * DIN + 16 * jn) = w; }
    }
    __syncthreads();
}
__device__ __forceinline__ void sample_out_tile(const Args& a, LAS unsigned char* lds, int layer, int it) {
    const int tid = fresh_tid(), lane = tid & 63, wave = __builtin_amdgcn_readfirstlane(tid >> 6);
    const int rt = it >> 3, ct = it & 7;
    SgB B; sg_loadB(B, (const bf16_t*)(a.ws + WS_WOUT) + (size_t)layer * D * D, ct * 128, wave, lane);
    sg_stage_bf16(lds, (const bf16_t*)(a.ws + WS_YMIX) + (size_t)(MP + 64 * rt) * D, tid);
    __syncthreads();
    f32x4 acc[2][4];
    if (sg_mma_reduce(lds, B, wave, lane, acc)) {
        const int fq = lane >> 4, lr = lane & 15, wc = wave & 3;
        const size_t off = (size_t)(64 * rt + lr) * D + ct * 128 + 32 * wc + 4 * fq;
        const float* res = (layer == 0 ? a.in[1] : (const float*)(a.ws + WS_X1S)) + off;
        float* yp = (float*)(a.ws + WS_YPRE) + off;
#pragma unroll
        for (int jn = 0; jn < 2; ++jn)
#pragma unroll
            for (int jt = 0; jt < 4; ++jt) { const f32x4 x = *(const f32x4*)(res + (size_t)(16 * jt) * D + 16 * jn);
                *(f32x4*)(yp + (size_t)(16 * jt) * D + 16 * jn) = x * DN_ALPHA + acc[jn][jt]; }
    }
    {
        asm volatile("s_waitcnt vmcnt(0)" ::: "memory");
        __syncthreads();
        if (tid == 0) { __builtin_amdgcn_fence(__ATOMIC_RELEASE, "agent"); asm volatile("s_waitcnt vmcnt(0)" ::: "memory");
            __hip_atomic_fetch_add((unsigned*)(a.ws + WS_CTL) + CW_SAMP + 64 * (8 * layer + rt), 1u, __ATOMIC_RELAXED, __HIP_MEMORY_SCOPE_AGENT); }
    }
    __syncthreads();
}
__device__ __forceinline__ void sample_final_ln_rows(const Args& a, int layer, int it) {
    const int tid = fresh_tid(), lane = tid & 63, wave = __builtin_amdgcn_readfirstlane(tid >> 6);
#if SAMPLE_OUT_KSLICE
    const int rt = it >> 5; const unsigned want = 32u;
#else
    const int rt = it >> 3, ct = it & 7; const unsigned want = 8u;
#endif
    if (wave == 0) {
        unsigned* cnt = (unsigned*)(a.ws + WS_CTL) + CW_SAMP + 64 * (8 * layer + rt); unsigned sp = 0;
        while ((unsigned)__builtin_amdgcn_readfirstlane(__hip_atomic_load(cnt, __ATOMIC_RELAXED, __HIP_MEMORY_SCOPE_AGENT)) < want) { __builtin_amdgcn_s_sleep(2); if (++sp > (1u << 20)) break; }
        __builtin_amdgcn_fence(__ATOMIC_ACQUIRE, "agent");
        asm volatile("s_waitcnt vmcnt(0)" ::: "memory");
    }
    __syncthreads();
#if SAMPLE_OUT_KSLICE
    if (wave >= 2) return;
    const int r = 64 * rt + 2 * (it & 31) + wave;
#else
    const int r = 64 * rt + 8 * ct + wave;
#endif
    const float* gamma = a.in[19] + layer * D; const float* beta = a.in[20] + layer * D;
    const float* Y = (const float*)(a.ws + WS_YPRE) + (size_t)r * D;
    float* o = layer == DEPTH - 1 ? a.out + O_YS + (size_t)r * D : (float*)(a.ws + WS_X1S) + (size_t)r * D;
    bf16_t* xn = layer == DEPTH - 1 ? nullptr : (bf16_t*)(a.ws + WS_XN) + (size_t)(MP + r) * D;
    f32x4 v[4]; float s = 0.f;
#pragma unroll
    for (int j = 0; j < 4; ++j) { v[j] = *(const f32x4*)(Y + 4 * lane + 256 * j); s += (v[j][0] + v[j][1]) + (v[j][2] + v[j][3]); }
    const float mean = wave_sum(s, lane) * (1.f / D); float s2 = 0.f;
#pragma unroll
    for (int j = 0; j < 4; ++j) { v[j] = v[j] - mean; s2 += (v[j][0] * v[j][0] + v[j][1] * v[j][1]) + (v[j][2] * v[j][2] + v[j][3] * v[j][3]); }
    const float rstd = rsqrtf(wave_sum(s2, lane) * (1.f / D) + LN_EPS);
#pragma unroll
    for (int j = 0; j < 4; ++j) { const f32x4 y = v[j] * rstd * *(const f32x4*)(gamma + 4 * lane + 256 * j) + *(const f32x4*)(beta + 4 * lane + 256 * j);
        *(f32x4*)(o + 4 * lane + 256 * j) = y;
        if (xn) { typedef unsigned u2_ __attribute__((ext_vector_type(2))); u2_ w; w.x = pk2(y[0], y[1]); w.y = pk2(y[2], y[3]); *(u2_*)(xn + 4 * lane + 256 * j) = w; } }
}
__device__ __forceinline__ void phase_sample_final_ln(const Args& a) {
    const int tid = fresh_tid(), lane = tid & 63, wave = __builtin_amdgcn_readfirstlane(tid >> 6);
    const int gw = fresh_bid() * NWAVES + wave, NGW = gridDim.x * NWAVES;
    const float* gamma = a.in[19] + (DEPTH - 1) * D; const float* beta = a.in[20] + (DEPTH - 1) * D;
    for (int r = gw; r < MS; r += NGW) {
        const float* Y = (const float*)(a.ws + WS_YPRE) + (size_t)r * D; float* o = a.out + O_YS + (size_t)r * D;
        f32x4 v[4]; float s = 0.f;
#pragma unroll
        for (int j = 0; j < 4; ++j) { v[j] = *(const f32x4*)(Y + 4 * lane + 256 * j); s += (v[j][0] + v[j][1]) + (v[j][2] + v[j][3]); }
        const float mean = wave_sum(s, lane) * (1.f / D); float s2 = 0.f;
#pragma unroll
        for (int j = 0; j < 4; ++j) { v[j] = v[j] - mean; s2 += (v[j][0] * v[j][0] + v[j][1] * v[j][1]) + (v[j][2] * v[j][2] + v[j][3] * v[j][3]); }
        const float rstd = rsqrtf(wave_sum(s2, lane) * (1.f / D) + LN_EPS);
#pragma unroll
        for (int j = 0; j < 4; ++j) *(f32x4*)(o + 4 * lane + 256 * j) = v[j] * rstd * *(const f32x4*)(gamma + 4 * lane + 256 * j) + *(const f32x4*)(beta + 4 * lane + 256 * j);
    }
}

__device__ __forceinline__ void sample_out_unit(const Args& a, LAS unsigned char* lds, int layer, int it) {
    const int tid = fresh_tid(), lane = tid & 63, wave = __builtin_amdgcn_readfirstlane(tid >> 6);
    const int rt = it >> 5, col0 = (it & 31) * 32;
    const int fq = lane >> 4, lr = lane & 15;
    const bf16_t* Ap = (const bf16_t*)(a.ws + WS_YMIX) + (size_t)(MP + 64 * rt + lr) * D + 128 * wave + 8 * fq;
    const bf16_t* Bp = (const bf16_t*)(a.ws + WS_WOUT) + (size_t)layer * D * D + (size_t)(col0 + lr) * D + 128 * wave + 8 * fq;
    bf16x8 Af[4][4], Bf[2][4];
#pragma unroll
    for (int jn = 0; jn < 2; ++jn)
#pragma unroll
        for (int kk = 0; kk < 4; ++kk) Bf[jn][kk] = *(const bf16x8*)(Bp + (size_t)(16 * jn) * D + 32 * kk);
#pragma unroll
    for (int jt = 0; jt < 4; ++jt)
#pragma unroll
        for (int kk = 0; kk < 4; ++kk) Af[jt][kk] = *(const bf16x8*)(Ap + (size_t)(16 * jt) * D + 32 * kk);
    const int jn_o = wave >> 2, jt_o = wave & 3;
    const size_t off = (size_t)(64 * rt + 16 * jt_o + lr) * D + col0 + 16 * jn_o + 4 * fq;
    const f32x4 x = *(const f32x4*)((layer == 0 ? a.in[1] : (const float*)(a.ws + WS_X1S)) + off);
    __builtin_amdgcn_sched_barrier(0);
    f32x4 acc[2][4];
#pragma unroll
    for (int i = 0; i < 2; ++i)
#pragma unroll
        for (int j = 0; j < 4; ++j) acc[i][j] = (f32x4){0.f, 0.f, 0.f, 0.f};
#pragma unroll
    for (int kk = 0; kk < 4; ++kk)
#pragma unroll
        for (int jt = 0; jt < 4; ++jt) { acc[0][jt] = MFMA16(Bf[0][kk], Af[jt][kk], acc[0][jt]); acc[1][jt] = MFMA16(Bf[1][kk], Af[jt][kk], acc[1][jt]); }
    LAS f32x4* xb = (LAS f32x4*)lds;
#pragma unroll
    for (int i = 0; i < 2; ++i)
#pragma unroll
        for (int j = 0; j < 4; ++j) xb[wave * 512 + (i * 4 + j) * 64 + lane] = acc[i][j];
    __syncthreads();
    f32x4 sum = xb[tid];
#pragma unroll
    for (int w = 1; w < 8; ++w) sum = sum + xb[w * 512 + tid];
    *(f32x4*)((float*)(a.ws + WS_YPRE) + off) = x * DN_ALPHA + sum;
    __syncthreads();
}
__device__ __forceinline__ void sample_in_unit(const Args& a, LAS unsigned char* lds, int layer, int it) {
    const int tid = fresh_tid(), lane = tid & 63, wave = __builtin_amdgcn_readfirstlane(tid >> 6);
    const int rt = it >> 5, col0 = (it & 31) * 96;
    const int fq = lane >> 4, lr = lane & 15;
    const bf16_t* Ap = (const bf16_t*)(a.ws + WS_XN) + (size_t)(MP + 64 * rt + lr) * D + 128 * wave + 8 * fq;
    const bf16_t* Bp = (const bf16_t*)(a.ws + WS_WIN) + (size_t)layer * DIN * D + (size_t)(col0 + lr) * D + 128 * wave + 8 * fq;
    bf16x8 Af[4][4], Bf[6][4];
#pragma unroll
    for (int jt = 0; jt < 4; ++jt)
#pragma unroll
        for (int kk = 0; kk < 4; ++kk) Af[jt][kk] = *(const bf16x8*)(Ap + (size_t)(16 * jt) * D + 32 * kk);
#pragma unroll
    for (int jn = 0; jn < 6; ++jn)
#pragma unroll
        for (int kk = 0; kk < 4; ++kk) Bf[jn][kk] = *(const bf16x8*)(Bp + (size_t)(16 * jn) * D + 32 * kk);
    __builtin_amdgcn_sched_barrier(0);
    LAS f32x4* xb = (LAS f32x4*)lds;
    bf16_t* proj = (bf16_t*)(a.ws + WS_PROJ) + (size_t)(MP + 64 * rt) * DIN + col0;
#pragma unroll
    for (int h = 0; h < 2; ++h) {
        f32x4 acc[3][4];
#pragma unroll
        for (int i = 0; i < 3; ++i)
#pragma unroll
            for (int j = 0; j < 4; ++j) acc[i][j] = (f32x4){0.f, 0.f, 0.f, 0.f};
#pragma unroll
        for (int kk = 0; kk < 4; ++kk)
#pragma unroll
            for (int jt = 0; jt < 4; ++jt)
#pragma unroll
                for (int i = 0; i < 3; ++i) acc[i][jt] = MFMA16(Bf[3 * h + i][kk], Af[jt][kk], acc[i][jt]);
        if (h) __syncthreads();
#pragma unroll
        for (int i = 0; i < 3; ++i)
#pragma unroll
            for (int j = 0; j < 4; ++j) xb[wave * 768 + (i * 4 + j) * 64 + lane] = acc[i][j];
        __syncthreads();
#pragma unroll
        for (int pp = 0; pp < 2; ++pp) {
            const int p = tid + 512 * pp;
            if (p < 768) {
                f32x4 sum = xb[p];
#pragma unroll
                for (int w = 1; w < 8; ++w) sum = sum + xb[w * 768 + p];
                const int pj = p >> 6, pl = p & 63, i = pj >> 2, jt = pj & 3;
                typedef unsigned u2 __attribute__((ext_vector_type(2))); u2 wv; wv.x = pk2(sum[0], sum[1]); wv.y = pk2(sum[2], sum[3]);
                *(u2*)(proj + (size_t)(16 * jt + (pl & 15)) * DIN + 48 * h + 16 * i + 4 * (pl >> 4)) = wv;
            }
        }
    }
    __syncthreads();
}
#if defined(PROBE_TIME) && PROBE_TIME >= 0
#define FSTAMP(k_) do { asm volatile("s_waitcnt vmcnt(0) lgkmcnt(0)" ::: "memory"); if (fresh_bid() == 0 && fresh_tid() == 0) { const unsigned long long t_ = __builtin_amdgcn_s_memrealtime(); \
        volatile LAS unsigned* ms_ = (volatile LAS unsigned*)(lds + MISC_OFF + 512); ms_[2 * (k_)] = (unsigned)t_; ms_[1 + 2 * (k_)] = (unsigned)(t_ >> 32); } } while (0)
#else
#define FSTAMP(k_) do { } while (0)
#endif
__device__ __forceinline__ void phase_gemm_in(const Args& a, LAS unsigned char* lds, int layer) {
    FSTAMP(24 + 2 * layer);
#if SAMPLE_IN_KSLICE
#if GIN_DEPHASE
    if (((fresh_bid() >> 3) & 1) == 0)
#endif
    sample_in_unit(a, lds, layer, fresh_bid());
#else
    { const int bid = fresh_bid(); if (bid < 192) sample_in_tile(a, lds, layer, bid); }
#endif
    FSTAMP(25 + 2 * layer);
    pg8::Gemm g{(const bf16_t*)(a.ws + WS_XN), (const bf16_t*)(a.ws + WS_WIN) + (size_t)layer * DIN * D, MP, DIN, D};
    pg8::StaticOrder S; S.init(MP, DIN, (int)gridDim.x, fresh_bid());
    pg8::EpiBf16<0> E{(bf16_t*)(a.ws + WS_PROJ), DIN, nullptr, 0, 0, 1.f};
    pg8::gemm_phase<pg8::EpiBf16<0>, pg8::StaticOrder, GIN_ALIGN, GIN_SP2>(lds, g, S, E);
#if SAMPLE_IN_KSLICE && GIN_DEPHASE
    if (((fresh_bid() >> 3) & 1) != 0) { __syncthreads(); sample_in_unit(a, lds, layer, fresh_bid()); }
#endif
}

__device__ __forceinline__ void phase_gemm_out(const Args& a, LAS unsigned char* lds, int layer) {
    unsigned* ctl = (unsigned*)(a.ws + WS_CTL);
#if SAMPLE_OUT_KSLICE
    FSTAMP(22); sample_out_unit(a, lds, layer, fresh_bid()); FSTAMP(23);
#else
    { const int bid = fresh_bid(); if (bid >= 192) sample_out_tile(a, lds, layer, bid - 192); }
#endif
    float* outp = layer == DEPTH - 1 ? a.out : nullptr;
    bf16_t* xn = layer == DEPTH - 1 ? nullptr : (bf16_t*)(a.ws + WS_XN);
    const float* base = nullptr;
    const bf16_t* base16 = (const bf16_t*)(a.ws + WS_XN);
    pg8::Gemm g{(const bf16_t*)(a.ws + WS_YMIX), (const bf16_t*)(a.ws + WS_WOUT) + (size_t)layer * D * D, MP, D, D};
    pg8::StaticOrder S; S.init(MP, D, (int)gridDim.x, fresh_bid());
#if RES_PREFETCH
    {
        pg8::Unit u0;
        if (S.next(0, u0)) {
            const int tid = fresh_tid(); const int wv = __builtin_amdgcn_readfirstlane(tid >> 6);
            const char* p = (const char*)base16 + ((size_t)(u0.pm * 256 + (tid >> 1)) * D + (size_t)u0.pn * 256) * 2 + (tid & 1) * 256;
            LAS unsigned* dump = (LAS unsigned*)(lds + MISC_OFF + 2048 + wv * 256);
            __builtin_amdgcn_global_load_lds((const unsigned*)p, dump, 4, 0, 0);
            __builtin_amdgcn_global_load_lds((const unsigned*)(p + 128), dump, 4, 0, 0);
        }
    }
#endif
    pg8::PanelStats st{(unsigned*)(a.ws + WS_XBUF + (size_t)layer * XBUF_LAYER), ctl + CW_SEAM + layer * SEAM_BANK, ctl + CW_TMO, 4, LN_EPS, 0x700u + (unsigned)layer * 0x40u};
#if SAMPLE_OUT_KSLICE
    st.pub = ctl + CW_SAMP + 64 * (8 * layer + (fresh_bid() >> 5));
#endif
    pg8::EpiDeepNorm E{base, base16, outp, xn, D, a.in[19] + layer * D, a.in[20] + layer * D, DN_ALPHA, st};
    pg8::gemm_phase<pg8::EpiDeepNorm, pg8::StaticOrder, false, true>(lds, g, S, E);
#if FINAL_LN_INLINE
#if SAMPLE_OUT_KSLICE
    { __syncthreads(); sample_final_ln_rows(a, layer, fresh_bid()); }
#else
    { const int bid = fresh_bid(); if (bid >= 192) { __syncthreads(); sample_final_ln_rows(a, layer, bid - 192); } }
#endif
#endif
}

typedef short s16x4 __attribute__((ext_vector_type(4)));
typedef float f32x2 __attribute__((ext_vector_type(2)));
typedef unsigned v2u __attribute__((ext_vector_type(2)));
#define DI __device__ __forceinline__
constexpr int NCHUNK = 272;
constexpr size_t WS_U = WS_YMIX;
constexpr size_t WS_ROPE = WS_MISC;
constexpr size_t WS_GATEW = WS_MISC + 1 * MiB;
constexpr size_t WS_RGA = WS_GATEW + 256 * 1024, WS_RGB = WS_RGA + 576 * 1024, WS_HST = WS_RGB + 576 * 1024, WS_CL = WS_HST + 576 * 1024;
constexpr size_t WS_LS = WS_CL + 272 * 1024;
constexpr size_t WS_LBT = WS_LS + 4096;
static_assert(WS_CL + (size_t)NCHUNK * 256 * 4 <= WS_LS && WS_LBT + 2048 <= WS_END && (size_t)NCHUNK * 8 * 4096 * 4 <= 34 * MiB && WS_ST + (size_t)NCHUNK * 8 * 4096 * 2 <= WS_P, "mixer scratch map");

DI void chunk_info(int ch, int& row0, int& pos0, int& q, int& c) {
    if (ch < 256) { q = ch >> 6; c = ch & 63; row0 = ch * 64; pos0 = c * 64; }
    else { q = NB + (ch - 256); c = 0; row0 = MP + (ch - 256) * DS; pos0 = PAST; }
}
DI bf16x8 pack8(const float (&v)[8]) { v4u o; o.x = pk2(v[0], v[1]); o.y = pk2(v[2], v[3]); o.z = pk2(v[4], v[5]); o.w = pk2(v[6], v[7]); return __builtin_bit_cast(bf16x8, o); }
DI void unpack8(const v4u w, float (&v)[8]) {
    v[0] = __uint_as_float(w.x << 16); v[1] = __uint_as_float(w.x & 0xffff0000u); v[2] = __uint_as_float(w.y << 16); v[3] = __uint_as_float(w.y & 0xffff0000u);
    v[4] = __uint_as_float(w.z << 16); v[5] = __uint_as_float(w.z & 0xffff0000u); v[6] = __uint_as_float(w.w << 16); v[7] = __uint_as_float(w.w & 0xffff0000u);
}
DI void load8f(const float* p, float (&v)[8]) { const f32x4 a = *(const f32x4*)p, b = *(const f32x4*)(p + 4); v[0] = a[0]; v[1] = a[1]; v[2] = a[2]; v[3] = a[3]; v[4] = b[0]; v[5] = b[1]; v[6] = b[2]; v[7] = b[3]; }
DI void load8f_lds(LAS const float* p, float (&v)[8]) { const f32x4 a = *(LAS const f32x4*)p, b = *(LAS const f32x4*)(p + 4); v[0] = a[0]; v[1] = a[1]; v[2] = a[2]; v[3] = a[3]; v[4] = b[0]; v[5] = b[1]; v[6] = b[2]; v[7] = b[3]; }
DI bf16x8 tr_frag(LAS const bf16_t* tile, int k0, int i0, int lane) {
    const int fq = lane >> 4, ii = lane & 15;
    LAS const bf16_t* p = tile + (k0 + 4 * fq + (ii >> 2)) * 64 + i0 + 4 * (ii & 3);
    const s16x4 lo = __builtin_amdgcn_ds_read_tr16_b64_v4i16((LAS s16x4*)p);
    const s16x4 hi = __builtin_amdgcn_ds_read_tr16_b64_v4i16((LAS s16x4*)(p + 16 * 64));
    return __builtin_shufflevector(lo, hi, 0, 1, 2, 3, 4, 5, 6, 7);
}
template <int L> DI void stage_tile(LAS bf16_t* dst, const bf16_t* src, int lane) {
#pragma unroll
    for (int p = 0; p < L / 8; ++p) { const int r = p * 8 + (lane >> 3), cc = (lane & 7) * 8; *(LAS v4u*)(dst + r * 64 + cc) = *(const v4u*)(src + (size_t)r * DIN + cc); }
}
DI float ret_log2g(int h) { return log1pf(-exp2f(-5.f - (float)h)) * 1.4426950408889634f; }

template <int L> DI void ut_product(LAS const bf16_t* vv, LAS const bf16_t* kd, bf16_t* ut, int lane) {
    f32x4 acc[4][4];
#pragma unroll
    for (int i = 0; i < 4; ++i)
#pragma unroll
        for (int j = 0; j < 4; ++j) acc[i][j] = (f32x4){0.f, 0.f, 0.f, 0.f};
#pragma unroll
    for (int ks = 0; ks < L / 32; ++ks) {
        bf16x8 xv[4], yk[4];
#pragma unroll
        for (int n = 0; n < 4; ++n) { xv[n] = tr_frag(vv, 32 * ks, 16 * n, lane); yk[n] = tr_frag(kd, 32 * ks, 16 * n, lane); }
#pragma unroll
        for (int nd = 0; nd < 4; ++nd)
#pragma unroll
            for (int ne = 0; ne < 4; ++ne) acc[nd][ne] = MFMA16(yk[nd], xv[ne], acc[nd][ne]);
    }
    const int fq = lane >> 4, lr = lane & 15;
#pragma unroll
    for (int nd = 0; nd < 4; ++nd)
#pragma unroll
        for (int ne = 0; ne < 4; ++ne) { v2u w; w.x = pk2(acc[nd][ne][0], acc[nd][ne][1]); w.y = pk2(acc[nd][ne][2], acc[nd][ne][3]);
            *(v2u*)(ut + (16 * ne + lr) * 64 + 16 * nd + 4 * fq) = w; }
}

template <int L> DI void tile_load(v4u (&r)[L / 8], const bf16_t* src, int lane) {
#pragma unroll
    for (int p = 0; p < L / 8; ++p) r[p] = *(const v4u*)(src + (size_t)(p * 8 + (lane >> 3)) * DIN + (lane & 7) * 8);
}
template <int L> DI void tile_store(LAS bf16_t* dst, const v4u (&r)[L / 8], int lane) {
#pragma unroll
    for (int p = 0; p < L / 8; ++p) *(LAS v4u*)(dst + (p * 8 + (lane >> 3)) * 64 + (lane & 7) * 8) = r[p];
}

template <int L> DI void ret_pass1(const Args& a, LAS unsigned char* wl, int ch, int h, int lane_in) {
    int lane = lane_in; asm volatile("" : "+v"(lane));
    int row0, pos0, q, c; chunk_info(ch, row0, pos0, q, c);
    LAS bf16_t* kd = (LAS bf16_t*)wl; LAS bf16_t* vv = kd + 4096;
    const bf16_t* proj = (const bf16_t*)(a.ws + WS_PROJ) + (size_t)row0 * DIN;
    const float* rcos = (const float*)(a.ws + WS_ROPE); const float* rsin = rcos + 4096 * 32;
    const float lg2 = ret_log2g(h);
    v4u vraw[L / 8], kraw[L / 16][2]; f32x4 kcs[L / 16][4];
    tile_load<L>(vraw, proj + C_RV + h * 64, lane);
#pragma unroll
    for (int it = 0; it < L / 16; ++it) {
        const int idx = it * 64 + lane, s = idx >> 2, jb = (idx & 3) * 8;
        const bf16_t* kr = proj + (size_t)s * DIN + C_RK + h * 64;
        kraw[it][0] = *(const v4u*)(kr + jb); kraw[it][1] = *(const v4u*)(kr + 32 + jb);
        const float* cp = rcos + (size_t)(pos0 + s) * 32 + jb; const float* sp = rsin + (size_t)(pos0 + s) * 32 + jb;
        kcs[it][0] = *(const f32x4*)cp; kcs[it][1] = *(const f32x4*)(cp + 4); kcs[it][2] = *(const f32x4*)sp; kcs[it][3] = *(const f32x4*)(sp + 4);
    }
    __builtin_amdgcn_sched_barrier(0);
    tile_store<L>(vv, vraw, lane);
#pragma unroll
    for (int it = 0; it < L / 16; ++it) {
        const int idx = it * 64 + lane, s = idx >> 2, jb = (idx & 3) * 8;
        float k1[8], k2[8], o1[8], o2[8];
        unpack8(kraw[it][0], k1); unpack8(kraw[it][1], k2);
        const float cs[8] = {kcs[it][0][0], kcs[it][0][1], kcs[it][0][2], kcs[it][0][3], kcs[it][1][0], kcs[it][1][1], kcs[it][1][2], kcs[it][1][3]};
        const float sn[8] = {kcs[it][2][0], kcs[it][2][1], kcs[it][2][2], kcs[it][2][3], kcs[it][3][0], kcs[it][3][1], kcs[it][3][2], kcs[it][3][3]};
        const float sc = exp2f((float)(L - 1 - s) * lg2);
#pragma unroll
        for (int j = 0; j < 8; ++j) { o1[j] = (k1[j] * cs[j] - k2[j] * sn[j]) * sc; o2[j] = (k2[j] * cs[j] + k1[j] * sn[j]) * sc; }
        *(LAS bf16x8*)(kd + s * 64 + jb) = pack8(o1); *(LAS bf16x8*)(kd + s * 64 + 32 + jb) = pack8(o2);
    }
    ut_product<L>(vv, kd, (bf16_t*)(a.ws + WS_U) + ((size_t)ch * 8 + h) * 4096, lane);
}

DI float row_scan16(float x) {
    x += __builtin_bit_cast(float, __builtin_amdgcn_update_dpp(0, __builtin_bit_cast(int, x), 0x111, 0xf, 0xf, true));
    x += __builtin_bit_cast(float, __builtin_amdgcn_update_dpp(0, __builtin_bit_cast(int, x), 0x112, 0xf, 0xf, true));
    x += __builtin_bit_cast(float, __builtin_amdgcn_update_dpp(0, __builtin_bit_cast(int, x), 0x114, 0xf, 0xf, true));
    x += __builtin_bit_cast(float, __builtin_amdgcn_update_dpp(0, __builtin_bit_cast(int, x), 0x118, 0xf, 0xf, true));
    return x;
}
template <int NT> struct HgRaw { v4u hf[NT][2]; f32x4 cst[2][4]; };
template <int NT, int KP0 = 0, int KP1 = 2> DI void hg_load_raw(HgRaw<NT>& R, const Args& a, const bf16_t* proj, int layer, int h, int fq, int lr) {
#pragma unroll
    for (int kp = KP0; kp < KP1; ++kp) {
        const int d0 = h * 64 + 8 * fq + 32 * kp;
        const float* p0 = (const float*)(a.ws + WS_LBT) + layer * 256 + d0; const float* p2 = a.in[15] + layer * 256 + d0;
        R.cst[kp][0] = *(const f32x4*)p0; R.cst[kp][1] = *(const f32x4*)(p0 + 4); R.cst[kp][2] = *(const f32x4*)p2; R.cst[kp][3] = *(const f32x4*)(p2 + 4);
#pragma unroll
        for (int t = 0; t < NT; ++t) R.hf[t][kp] = *(const v4u*)(proj + (size_t)(16 * t + lr) * DIN + C_HF + d0);
    }
}
template <int NT, bool PACK, int KP0 = 0, int KP1 = 2> DI void hg_forget(const HgRaw<NT>& R, int layer, int fq, int lr, float (&cum)[NT][2][8], float (&kcf)[NT][2][8], bf16x8 (&Kc)[NT][2]) {
    const int lane = (fq << 4) | lr;
#pragma unroll
    for (int kp = KP0; kp < KP1; ++kp) {
        float lb[8], bs[8], car[8];
#pragma unroll
        for (int j = 0; j < 8; ++j) { lb[j] = R.cst[kp][j >> 2][j & 3]; bs[j] = R.cst[kp][2 + (j >> 2)][j & 3]; car[j] = 0.f; }
#pragma unroll
        for (int t = 0; t < NT; ++t) {
            float hf[8], kc[8];
            unpack8(R.hf[t][kp], hf);
#pragma unroll
            for (int j = 0; j < 8; ++j) {
                const float z = hf[j] + bs[j];
                const float ez = fexp(-fminf(fmaxf(z, -30.f), 30.f));
                const float sg = frcp(1.f + ez);
                const float lf = __builtin_amdgcn_logf(fmaxf(lb[j] + (1.f - lb[j]) * sg, F_EPS));
                kc[j] = (1.f - lb[j]) * ez * sg;
                const float cl = row_scan16(lf) + car[j];
                cum[t][kp][j] = cl;
                if (t + 1 < NT) car[j] = sh_row15(cl, lane);
            }
            if (PACK) Kc[t][kp] = pack8(kc);
            else {
#pragma unroll
                for (int j = 0; j < 8; ++j) kcf[t][kp][j] = kc[j];
            }
        }
    }
}
template <int L> DI void hg_pass1(const Args& a, LAS unsigned char* wl, int layer, int ch, int h, int lane_in) {
    constexpr int NT = L / 16;
    int lane = lane_in; asm volatile("" : "+v"(lane));
    int row0, pos0, q, c; chunk_info(ch, row0, pos0, q, c);
    const int fq = lane >> 4, lr = lane & 15;
    LAS bf16_t* kd = (LAS bf16_t*)wl; LAS bf16_t* vv = kd + 4096;
    const bf16_t* proj = (const bf16_t*)(a.ws + WS_PROJ) + (size_t)row0 * DIN;
    float cum[NT][2][8]; bf16x8 Kc[NT][2];
    v4u vraw[L / 8];
    { HgRaw<NT> R; float (&kdummy)[NT][2][8] = *(float (*)[NT][2][8])nullptr;
      hg_load_raw<NT, 0, 1>(R, a, proj, layer, h, fq, lr); tile_load<L>(vraw, proj + C_HI + h * 64, lane);
      __builtin_amdgcn_sched_barrier(0);
      hg_load_raw<NT, 1, 2>(R, a, proj, layer, h, fq, lr);
      tile_store<L>(vv, vraw, lane);
      hg_forget<NT, true, 0, 1>(R, layer, fq, lr, cum, kdummy, Kc);
      __builtin_amdgcn_sched_barrier(0);
      hg_forget<NT, true, 1, 2>(R, layer, fq, lr, cum, kdummy, Kc); }
#pragma unroll
    for (int kp = 0; kp < 2; ++kp) {
        float cl[8];
#pragma unroll
        for (int j = 0; j < 8; ++j) cl[j] = sh_row15(cum[NT - 1][kp][j], lane);
        if (lr == 0) { float* clp = (float*)(a.ws + WS_CL) + (size_t)ch * 256 + h * 64 + 8 * fq + 32 * kp;
            *(f32x4*)clp = (f32x4){cl[0], cl[1], cl[2], cl[3]}; *(f32x4*)(clp + 4) = (f32x4){cl[4], cl[5], cl[6], cl[7]}; }
#pragma unroll
        for (int t = 0; t < NT; ++t) {
            float kc[8], o[8];
            unpack8(__builtin_bit_cast(v4u, Kc[t][kp]), kc);
#pragma unroll
            for (int j = 0; j < 8; ++j) o[j] = kc[j] * __builtin_amdgcn_exp2f(cl[j] - cum[t][kp][j]);
            *(LAS bf16x8*)(kd + (16 * t + lr) * 64 + 8 * fq + 32 * kp) = pack8(o);
        }
    }
    ut_product<L>(vv, kd, (bf16_t*)(a.ws + WS_U) + ((size_t)ch * 8 + 4 + h) * 4096, lane);
}

template <int L> DI void rg_pass1(const Args& a, int layer, int ch, int g, int lane_in) {
    constexpr int NT = L / 16;
    int lane = lane_in; asm volatile("" : "+v"(lane));
#if PROBE_PK
    {
        float s0 = (float)lane, s1 = s0 + 1.f, s2 = s0 + 2.f, s3 = s0 + 3.f, s4 = s0 + 4.f, s5 = s0 + 5.f, s6 = s0 + 6.f, s7 = s0 + 7.f; const float c1 = 0.999f, c2 = 0.001f;
        f32x2 p0 = {s0, s1}, p1 = {s2, s3}, p2 = {s4, s5}, p3 = {s6, s7}; const f32x2 q1 = {c1, c1}, q2 = {c2, c2};
#pragma unroll 1
        for (int rep = 0; rep < 256; ++rep) {
            if (PROBE_PK == 1) asm volatile("v_fma_f32 %0, %0, %8, %9\n\tv_fma_f32 %1, %1, %8, %9\n\tv_fma_f32 %2, %2, %8, %9\n\tv_fma_f32 %3, %3, %8, %9\n\tv_fma_f32 %4, %4, %8, %9\n\tv_fma_f32 %5, %5, %8, %9\n\tv_fma_f32 %6, %6, %8, %9\n\tv_fma_f32 %7, %7, %8, %9"
                : "+v"(s0), "+v"(s1), "+v"(s2), "+v"(s3), "+v"(s4), "+v"(s5), "+v"(s6), "+v"(s7) : "v"(c1), "v"(c2));
            else asm volatile("v_pk_fma_f32 %0, %0, %4, %5\n\tv_pk_fma_f32 %1, %1, %4, %5\n\tv_pk_fma_f32 %2, %2, %4, %5\n\tv_pk_fma_f32 %3, %3, %4, %5"
                : "+v"(p0), "+v"(p1), "+v"(p2), "+v"(p3) : "v"(q1), "v"(q2));
        }
        const float sink = (s0 + s1 + s2 + s3) + (s4 + s5 + s6 + s7) + (p0[0] + p0[1] + p1[0] + p1[1]) + (p2[0] + p2[1] + p3[0] + p3[1]);
        if (sink == 123456.75f) ((float*)(a.ws + WS_LS))[2001] = sink;
    }
#endif
    int row0, pos0, q, c; chunk_info(ch, row0, pos0, q, c);
    const int fq = lane >> 4, lr = lane & 15;
    const bf16_t* projx = (const bf16_t*)(a.ws + WS_PROJ) + (size_t)row0 * DIN + C_RGX + g * 64;
    const float* cw = a.in[7] + (size_t)layer * 4 * 512 + g * 64; const float* cbp = a.in[8] + (size_t)layer * 512 + g * 64;
    const bool prev_rows = (ch < 256) && (c > 0), is_sample = ch >= 256;
    const float* cache = a.in[2] + ((size_t)layer * 16 + (is_sample ? q - NB : 0)) * 3 * 512 + g * 64;
    bf16x8 Af[NT][2];
#pragma unroll
    for (int kp = 0; kp < 2; ++kp) {
        const int cin0 = 8 * fq + 32 * kp;
        v4u raw[NT][4]; float xb[3][8];
#pragma unroll
        for (int m = 0; m < NT; ++m)
#pragma unroll
            for (int j = 0; j < 4; ++j) {
                const int tt = 16 * m + lr - 3 + j;
                const bool inrow = (m > 0) || tt >= 0 || prev_rows;
                raw[m][j] = *(const v4u*)(projx + (ptrdiff_t)(inrow ? tt : 0) * DIN + cin0);
            }
#pragma unroll
        for (int j = 0; j < 3; ++j) { const int tt = lr - 3 + j; load8f(cache + (size_t)(tt < 0 ? 3 + tt : 0) * 512 + cin0, xb[j]); }
        float w0[8], w1[8], w2[8], w3[8], cb[8];
        load8f(cw + 0 * 512 + cin0, w0); load8f(cw + 1 * 512 + cin0, w1); load8f(cw + 2 * 512 + cin0, w2); load8f(cw + 3 * 512 + cin0, w3); load8f(cbp + cin0, cb);
#pragma unroll
        for (int m = 0; m < NT; ++m) {
            float x[4][8];
#pragma unroll
            for (int j = 0; j < 4; ++j) {
                unpack8(raw[m][j], x[j]);
                if (m == 0 && j < 3) { const int tt = lr - 3 + j; const bool inrow = tt >= 0 || prev_rows;
#pragma unroll
                    for (int e = 0; e < 8; ++e) x[j][e] = inrow ? x[j][e] : (is_sample ? xb[j][e] : 0.f); }
            }
            float u[8];
#pragma unroll
            for (int e = 0; e < 8; ++e) u[e] = cb[e] + w0[e] * x[0][e] + w1[e] * x[1][e] + w2[e] * x[2][e] + w3[e] * x[3][e];
            Af[m][kp] = pack8(u);
        }
        if (kp == 0) __builtin_amdgcn_sched_barrier(0);
    }
#if PROBE_MFMA
    {
        f32x4 d0 = {0.f, 0.f, 0.f, 0.f}, d1 = d0, d2 = d0, d3 = d0;
#pragma unroll 1
        for (int rep = 0; rep < PROBE_MFMA / 4; ++rep) {
            d0 = MFMA16(Af[0][0], Af[1][0], d0); d1 = MFMA16(Af[0][1], Af[1][1], d1); d2 = MFMA16(Af[1][0], Af[0][0], d2); d3 = MFMA16(Af[1][1], Af[0][1], d3);
        }
        const f32x4 ds = d0 + d1 + d2 + d3; asm volatile("" :: "v"(ds[0] + ds[1] + ds[2] + ds[3]));
    }
#endif
    bf16x8 idc[2], idt[2];
#pragma unroll
    for (int p = 0; p < 2; ++p)
#pragma unroll
        for (int j = 0; j < 8; ++j) { idc[p][j] = (16 * p + lr - 8 * fq == j) ? (short)0x3F80 : (short)0; idt[p][j] = ((j >> 2) == p && (j & 3) == lr - 4 * fq) ? (short)0x3F80 : (short)0; }
    const bf16_t* gw = (const bf16_t*)(a.ws + WS_GATEW) + ((size_t)(layer * 2) * 8 + g) * 4096;
    bf16_t* Pout = (bf16_t*)(a.ws + WS_P) + (size_t)row0 * 512 + g * 64;
    bf16_t* Hout = (bf16_t*)(a.ws + WS_HL) + (size_t)row0 * 512 + g * 64;
    bf16x8 nya0, nya1, nyx0, nyx1; float nbac, nbxc, nls;
#define RG_LOADW(n_) do { const int cc_ = 16 * (n_) + lr, chn_ = g * 64 + cc_; \
        nya0 = *(const bf16x8*)(gw + (size_t)cc_ * 64 + 8 * fq); nya1 = *(const bf16x8*)(gw + (size_t)cc_ * 64 + 32 + 8 * fq); \
        nyx0 = *(const bf16x8*)(gw + 8 * 4096 + (size_t)cc_ * 64 + 8 * fq); nyx1 = *(const bf16x8*)(gw + 8 * 4096 + (size_t)cc_ * 64 + 32 + 8 * fq); \
        nbac = -1.4426950408889634f * a.in[10][layer * 512 + chn_]; nbxc = -1.4426950408889634f * a.in[12][layer * 512 + chn_]; nls = ((const float*)(a.ws + WS_LS))[layer * 512 + chn_]; } while (0)
    RG_LOADW(0);
#pragma unroll 1
    for (int n = 0; n < 4; ++n) {
        const int cc = 16 * n + lr, chn = g * 64 + cc;
        const bf16x8 ya0 = nya0, ya1 = nya1, yx0 = nyx0, yx1 = nyx1;
        const float bac = nbac, bxc = nbxc, ls = nls;
        RG_LOADW(n < 3 ? n + 1 : 3);
        const bf16x8 idn = (n & 1) ? idc[1] : idc[0];
        float Arun = 1.f, Brun = 0.f;
        float Al[NT][4], Bl[NT][4];
#pragma unroll
        for (int m = 0; m < NT; ++m) {
            f32x4 accr = (f32x4){0.f, 0.f, 0.f, 0.f}, accx = accr, accu = accr;
            accr = MFMA16(Af[m][0], ya0, accr); accr = MFMA16(Af[m][1], ya1, accr);
            accx = MFMA16(Af[m][0], yx0, accx); accx = MFMA16(Af[m][1], yx1, accx);
            accu = (n & 2) ? MFMA16(Af[m][1], idn, accu) : MFMA16(Af[m][0], idn, accu);
            float omv[4], avv[4], giu[4], xmin = 0.f;
#pragma unroll
            for (int r = 0; r < 4; ++r) {
                const float rr = frcp(1.f + __builtin_amdgcn_exp2f(accr[r] + bac)), gi = frcp(1.f + __builtin_amdgcn_exp2f(accx[r] + bxc));
                const float x2 = rr * ls;
                const float av = __builtin_amdgcn_exp2f(x2 * 0.72134752044448170f);
                float om = -x2 * (1.f + x2 * (0.5f + x2 * (1.f / 6.f + x2 * (1.f / 24.f))));
                xmin = fminf(xmin, x2); omv[r] = om; avv[r] = av; giu[r] = gi * accu[r];
            }
            if (__builtin_amdgcn_ballot_w64(xmin < -0.25f) != 0ull) {
#pragma unroll
                for (int r = 0; r < 4; ++r) omv[r] = (omv[r] > 0.2212f) ? __builtin_fmaf(-avv[r], avv[r], 1.f) : omv[r];
            }
#pragma unroll
            for (int r = 0; r < 4; ++r) {
                const float av = avv[r], bv = __builtin_amdgcn_sqrtf(omv[r]) * giu[r];
                if (r == 0) { Al[m][0] = av; Bl[m][0] = bv; } else { Al[m][r] = av * Al[m][r - 1]; Bl[m][r] = av * Bl[m][r - 1] + bv; }
            }
        }
        float A4[NT], B4[NT], PA[NT], PB[NT];
#pragma unroll
        for (int m = 0; m < NT; ++m) { A4[m] = Al[m][3]; B4[m] = Bl[m][3]; }
        { float Ap[NT], Bp[NT]; const bool od = (fq & 1) != 0;
#pragma unroll
          for (int m = 0; m < NT; ++m) { Ap[m] = shx(A4[m], 16, lane); Bp[m] = shx(B4[m], 16, lane); }
#pragma unroll
          for (int m = 0; m < NT; ++m) { PA[m] = od ? Ap[m] : 1.f; PB[m] = od ? Bp[m] : 0.f;
              B4[m] = (od ? Bp[m] : B4[m]) * (od ? A4[m] : Ap[m]) + (od ? B4[m] : Bp[m]); A4[m] = A4[m] * Ap[m]; } }
        { float Ap[NT], Bp[NT]; const bool od = (fq & 2) != 0;
#pragma unroll
          for (int m = 0; m < NT; ++m) { Ap[m] = shx(A4[m], 32, lane); Bp[m] = shx(B4[m], 32, lane); }
#pragma unroll
          for (int m = 0; m < NT; ++m) { PB[m] = od ? Bp[m] * PA[m] + PB[m] : PB[m]; PA[m] = od ? Ap[m] * PA[m] : PA[m];
              B4[m] = (od ? Bp[m] : B4[m]) * (od ? A4[m] : Ap[m]) + (od ? B4[m] : Bp[m]); A4[m] = A4[m] * Ap[m]; } }
#pragma unroll
        for (int kt = 0; kt < NT / 2; ++kt) {
            float Pv[8], Hv[8];
#pragma unroll
            for (int hh = 0; hh < 2; ++hh) {
                const int m = 2 * kt + hh;
                const float PAin = PA[m] * Arun, PBin = PA[m] * Brun + PB[m];
#pragma unroll
                for (int r = 0; r < 4; ++r) { Pv[4 * hh + r] = Al[m][r] * PAin; Hv[4 * hh + r] = Al[m][r] * PBin + Bl[m][r]; }
                Brun = A4[m] * Brun + B4[m]; Arun = A4[m] * Arun;
            }
            const bf16x8 Xp = pack8(Pv), Xh = pack8(Hv);
#pragma unroll
            for (int hh = 0; hh < 2; ++hh) {
                const int tp = 16 * (2 * kt + hh) + lr;
                f32x4 z = (f32x4){0.f, 0.f, 0.f, 0.f};
                const f32x4 op = MFMA16(Xp, idt[hh], z), oh = MFMA16(Xh, idt[hh], z);
                v2u wp, wh; wp.x = pk2(op[0], op[1]); wp.y = pk2(op[2], op[3]); wh.x = pk2(oh[0], oh[1]); wh.y = pk2(oh[2], oh[3]);
                *(v2u*)(Pout + (size_t)tp * 512 + 16 * n + 4 * fq) = wp; *(v2u*)(Hout + (size_t)tp * 512 + 16 * n + 4 * fq) = wh;
            }
        }
        if (fq == 0) { ((float*)(a.ws + WS_RGA))[(size_t)ch * 512 + chn] = Arun; ((float*)(a.ws + WS_RGB))[(size_t)ch * 512 + chn] = Brun; }
    }
#undef RG_LOADW
}

template <int L> DI void rg_pass2(const Args& a, int layer, int ch, int g, int lane_in) {
    int lane = lane_in; asm volatile("" : "+v"(lane));
    int row0, pos0, q, c; chunk_info(ch, row0, pos0, q, c);
    const int rr = lane >> 3, c0 = (lane & 7) * 8;
    float hs[8]; load8f((const float*)(a.ws + WS_HST) + (size_t)ch * 512 + g * 64 + c0, hs);
    const bf16_t* Pp = (const bf16_t*)(a.ws + WS_P) + (size_t)row0 * 512 + g * 64 + c0;
    const bf16_t* Hp = (const bf16_t*)(a.ws + WS_HL) + (size_t)row0 * 512 + g * 64 + c0;
    const bf16_t* Gp = (const bf16_t*)(a.ws + WS_PROJ) + (size_t)row0 * DIN + C_RGG + g * 64 + c0;
    bf16_t* ymix = (bf16_t*)(a.ws + WS_YMIX) + (size_t)row0 * D + g * 64 + c0;
    v4u praw[L / 8], hraw[L / 8], graw[L / 8];
#pragma unroll
    for (int it = 0; it < L / 8; ++it) { const int t = it * 8 + rr; praw[it] = *(const v4u*)(Pp + (size_t)t * 512); hraw[it] = *(const v4u*)(Hp + (size_t)t * 512); graw[it] = *(const v4u*)(Gp + (size_t)t * DIN); }
    __builtin_amdgcn_sched_barrier(0);
#pragma unroll
    for (int it = 0; it < L / 8; ++it) {
        const int t = it * 8 + rr;
        float pv[8], hv[8], gv[8], y[8];
        unpack8(praw[it], pv); unpack8(hraw[it], hv); unpack8(graw[it], gv);
#pragma unroll
        for (int j = 0; j < 8; ++j) y[j] = (hv[j] + pv[j] * hs[j]) * gv[j] * sigmoidf_(gv[j]);
        *(bf16x8*)(ymix + (size_t)t * D) = pack8(y);
    }
}

template <int L> DI void ret_pass2(const Args& a, LAS unsigned char* wl, int layer, int ch, int h, int lane_in) {
    int lane = lane_in; asm volatile("" : "+v"(lane));
    constexpr int NT = L / 16, KS = L / 32;
    int row0, pos0, q, c; chunk_info(ch, row0, pos0, q, c);
    const int fq = lane >> 4, lr = lane & 15;
    LAS bf16_t* vv = (LAS bf16_t*)wl;
    const bf16_t* proj = (const bf16_t*)(a.ws + WS_PROJ) + (size_t)row0 * DIN;
    const float* rcos = (const float*)(a.ws + WS_ROPE); const float* rsin = rcos + 4096 * 32;
    const bf16_t* st = (const bf16_t*)(a.ws + WS_ST) + ((size_t)ch * 8 + h) * 4096;
    const float* gnp = a.in[14] + layer * 256 + h * 64 + 4 * fq;
    bf16_t* ymix = (bf16_t*)(a.ws + WS_YMIX) + (size_t)row0 * D + 512 + h * 64;
    const float lg2 = ret_log2g(h);
    v4u vraw[L / 8], kraw[NT][2]; f32x4 kcs[NT][4]; bf16x8 Sf[4][2]; f32x4 gq[4];
#pragma unroll
    for (int p = 0; p < L / 8; ++p) vraw[p] = *(const v4u*)(proj + (size_t)(p * 8 + (lane >> 3)) * DIN + C_RV + h * 64 + (lane & 7) * 8);
#pragma unroll
    for (int t = 0; t < NT; ++t) { const int s = 16 * t + lr; const bf16_t* kr = proj + (size_t)s * DIN + C_RK + h * 64 + 8 * fq;
        kraw[t][0] = *(const v4u*)kr; kraw[t][1] = *(const v4u*)(kr + 32);
        const float* cp = rcos + (size_t)(pos0 + s) * 32 + 8 * fq; const float* sp = rsin + (size_t)(pos0 + s) * 32 + 8 * fq;
        kcs[t][0] = *(const f32x4*)cp; kcs[t][1] = *(const f32x4*)(cp + 4); kcs[t][2] = *(const f32x4*)sp; kcs[t][3] = *(const f32x4*)(sp + 4); }
#pragma unroll
    for (int ne = 0; ne < 4; ++ne) { Sf[ne][0] = *(const bf16x8*)(st + (16 * ne + lr) * 64 + 8 * fq); Sf[ne][1] = *(const bf16x8*)(st + (16 * ne + lr) * 64 + 32 + 8 * fq); gq[ne] = *(const f32x4*)(gnp + 16 * ne); }
    __builtin_amdgcn_sched_barrier(0);
#pragma unroll
    for (int p = 0; p < L / 8; ++p) *(LAS v4u*)(vv + (p * 8 + (lane >> 3)) * 64 + (lane & 7) * 8) = vraw[p];
    bf16x8 Kf[NT][2];
#pragma unroll
    for (int t = 0; t < NT; ++t) {
        const int s = 16 * t + lr;
        float k1[8], k2[8], o1[8], o2[8];
        unpack8(kraw[t][0], k1); unpack8(kraw[t][1], k2);
        const float cs[8] = {kcs[t][0][0], kcs[t][0][1], kcs[t][0][2], kcs[t][0][3], kcs[t][1][0], kcs[t][1][1], kcs[t][1][2], kcs[t][1][3]};
        const float sn[8] = {kcs[t][2][0], kcs[t][2][1], kcs[t][2][2], kcs[t][2][3], kcs[t][3][0], kcs[t][3][1], kcs[t][3][2], kcs[t][3][3]};
        const float gk = exp2f(-(float)(s + 1) * lg2);
#pragma unroll
        for (int j = 0; j < 8; ++j) { o1[j] = (k1[j] * cs[j] - k2[j] * sn[j]) * gk; o2[j] = (k2[j] * cs[j] + k1[j] * sn[j]) * gk; }
        Kf[t][0] = pack8(o1); Kf[t][1] = pack8(o2);
    }
    v4u qraw[2]; f32x4 qcs[4]; v2u graw[4];
#define RET_LOADQ(b_) do { const int l_ = 16 * (b_) + lr; const bf16_t* qr_ = proj + (size_t)l_ * DIN + C_RQ + h * 64 + 8 * fq; \
        qraw[0] = *(const v4u*)qr_; qraw[1] = *(const v4u*)(qr_ + 32); \
        const float* cp_ = rcos + (size_t)(pos0 + l_) * 32 + 8 * fq; const float* sp_ = rsin + (size_t)(pos0 + l_) * 32 + 8 * fq; \
        qcs[0] = *(const f32x4*)cp_; qcs[1] = *(const f32x4*)(cp_ + 4); qcs[2] = *(const f32x4*)sp_; qcs[3] = *(const f32x4*)(sp_ + 4); \
        _Pragma("unroll") for (int ne_ = 0; ne_ < 4; ++ne_) graw[ne_] = *(const v2u*)(proj + (size_t)l_ * DIN + C_RG + h * 64 + 16 * ne_ + 4 * fq); } while (0)
    RET_LOADQ(0);
#pragma unroll 1
    for (int b = 0; b < NT; ++b) {
        const int l = 16 * b + lr;
        const v4u q0 = qraw[0], q1r = qraw[1]; const f32x4 c0 = qcs[0], c1 = qcs[1], s0 = qcs[2], s1 = qcs[3]; const v2u g0r = graw[0], g1r = graw[1], g2r = graw[2], g3r = graw[3];
        RET_LOADQ(b + 1 < NT ? b + 1 : b);
        __builtin_amdgcn_sched_barrier(0);
        bf16x8 Qh[2];
        {
            float q1[8], q2[8], o1[8], o2[8];
            unpack8(q0, q1); unpack8(q1r, q2);
            const float cs[8] = {c0[0], c0[1], c0[2], c0[3], c1[0], c1[1], c1[2], c1[3]}, sn[8] = {s0[0], s0[1], s0[2], s0[3], s1[0], s1[1], s1[2], s1[3]};
            const float gl = 0.125f * exp2f((float)(l + 1) * lg2);
#pragma unroll
            for (int j = 0; j < 8; ++j) { o1[j] = gl * (q1[j] * cs[j] - q2[j] * sn[j]); o2[j] = gl * (q2[j] * cs[j] + q1[j] * sn[j]); }
            Qh[0] = pack8(o1); Qh[1] = pack8(o2);
        }
        f32x4 sc[NT];
#pragma unroll
        for (int t = 0; t < NT; ++t) {
            sc[t] = (f32x4){0.f, 0.f, 0.f, 0.f};
            if (t <= b) {
                sc[t] = MFMA16(Kf[t][0], Qh[0], sc[t]); sc[t] = MFMA16(Kf[t][1], Qh[1], sc[t]);
                if (t == b) {
#pragma unroll
                    for (int r = 0; r < 4; ++r) if (4 * fq + r > lr) sc[t][r] = 0.f;
                }
            }
        }
        f32x4 O[4];
#pragma unroll
        for (int ne = 0; ne < 4; ++ne) { O[ne] = (f32x4){0.f, 0.f, 0.f, 0.f}; O[ne] = MFMA16(Sf[ne][0], Qh[0], O[ne]); O[ne] = MFMA16(Sf[ne][1], Qh[1], O[ne]); }
#pragma unroll
        for (int ks = 0; ks < KS; ++ks) {
            if (2 * ks <= b) {
                const float pv[8] = {sc[2 * ks][0], sc[2 * ks][1], sc[2 * ks][2], sc[2 * ks][3], sc[2 * ks + 1][0], sc[2 * ks + 1][1], sc[2 * ks + 1][2], sc[2 * ks + 1][3]};
                const bf16x8 Pf = pack8(pv);
#pragma unroll
                for (int ne = 0; ne < 4; ++ne) O[ne] = MFMA16(tr_frag(vv, 32 * ks, 16 * ne, lane), Pf, O[ne]);
            }
        }
        float sm = 0.f;
#pragma unroll
        for (int ne = 0; ne < 4; ++ne) sm += (O[ne][0] + O[ne][1]) + (O[ne][2] + O[ne][3]);
        sm += shx(sm, 16, lane); sm += shx(sm, 32, lane);
        const float mu = sm * (1.f / 64.f);
        float vq = 0.f;
#pragma unroll
        for (int ne = 0; ne < 4; ++ne)
#pragma unroll
            for (int r = 0; r < 4; ++r) { const float dl = O[ne][r] - mu; vq += dl * dl; }
        vq += shx(vq, 16, lane); vq += shx(vq, 32, lane);
        const float rstd = rsqrtf(vq * (1.f / 64.f) + LN_EPS);
        const v2u gr[4] = {g0r, g1r, g2r, g3r};
#pragma unroll
        for (int ne = 0; ne < 4; ++ne) {
            const v2u gw = gr[ne];
            const float g0 = __uint_as_float(gw.x << 16), g1 = __uint_as_float(gw.x & 0xffff0000u), g2 = __uint_as_float(gw.y << 16), g3 = __uint_as_float(gw.y & 0xffff0000u);
            const float y0 = (O[ne][0] - mu) * rstd * gq[ne][0] * g0 * sigmoidf_(g0), y1 = (O[ne][1] - mu) * rstd * gq[ne][1] * g1 * sigmoidf_(g1);
            const float y2 = (O[ne][2] - mu) * rstd * gq[ne][2] * g2 * sigmoidf_(g2), y3 = (O[ne][3] - mu) * rstd * gq[ne][3] * g3 * sigmoidf_(g3);
            v2u o; o.x = pk2(y0, y1); o.y = pk2(y2, y3);
            *(v2u*)(ymix + (size_t)l * D + 16 * ne + 4 * fq) = o;
        }
    }
#undef RET_LOADQ
}

template <int L> DI void hg_pass2(const Args& a, LAS unsigned char* wl, int layer, int ch, int h, int lane_in) {
    constexpr int NT = L / 16, KS = L / 32;
    int lane = lane_in; asm volatile("" : "+v"(lane));
    int row0, pos0, q, c; chunk_info(ch, row0, pos0, q, c);
    const int fq = lane >> 4, lr = lane & 15;
    LAS bf16_t* vv = (LAS bf16_t*)wl;
    const bf16_t* proj = (const bf16_t*)(a.ws + WS_PROJ) + (size_t)row0 * DIN;
    const bf16_t* st = (const bf16_t*)(a.ws + WS_ST) + ((size_t)ch * 8 + 4 + h) * 4096;
    const float* gnp = a.in[17] + layer * 256 + h * 64 + 4 * fq;
    bf16_t* ymix = (bf16_t*)(a.ws + WS_YMIX) + (size_t)row0 * D + 768 + h * 64;
    float cum[NT][2][8]; bf16x8 Kc[NT][2];
    {
        v4u vraw[L / 8]; HgRaw<NT> R; float (&kdummy)[NT][2][8] = *(float (*)[NT][2][8])nullptr;
        tile_load<L>(vraw, proj + C_HI + h * 64, lane); hg_load_raw<NT, 0, 1>(R, a, proj, layer, h, fq, lr);
        __builtin_amdgcn_sched_barrier(0);
        hg_load_raw<NT, 1, 2>(R, a, proj, layer, h, fq, lr);
        tile_store<L>(vv, vraw, lane);
        hg_forget<NT, true, 0, 1>(R, layer, fq, lr, cum, kdummy, Kc);
        __builtin_amdgcn_sched_barrier(0);
        hg_forget<NT, true, 1, 2>(R, layer, fq, lr, cum, kdummy, Kc);
    }
    LAS bf16x8* kcL = (LAS bf16x8*)(wl + 8192);
#pragma unroll
    for (int t = 0; t < NT; ++t) { kcL[(2 * t) * 64 + lane] = Kc[t][0]; kcL[(2 * t + 1) * 64 + lane] = Kc[t][1]; }
    v4u qraw[NT][2]; v2u graw[NT][4];
#define HG_LOADQ(b_) do { const int t_ = 16 * (b_) + lr; \
        qraw[b_][0] = *(const v4u*)(proj + (size_t)t_ * DIN + C_HQ + h * 64 + 8 * fq); qraw[b_][1] = *(const v4u*)(proj + (size_t)t_ * DIN + C_HQ + h * 64 + 32 + 8 * fq); \
        _Pragma("unroll") for (int ne_ = 0; ne_ < 4; ++ne_) graw[b_][ne_] = *(const v2u*)(proj + (size_t)t_ * DIN + C_HG + h * 64 + 16 * ne_ + 4 * fq); } while (0)
#pragma unroll
    for (int b = 0; b < NT; ++b) {
        const int t = 16 * b + lr;
        HG_LOADQ(b);
        bf16x8 Sf[4][2];
#pragma unroll
        for (int ne = 0; ne < 4; ++ne) { Sf[ne][0] = *(const bf16x8*)(st + (16 * ne + lr) * 64 + 8 * fq); Sf[ne][1] = *(const bf16x8*)(st + (16 * ne + lr) * 64 + 32 + 8 * fq); }
        f32x4 gq[4];
#pragma unroll
        for (int ne = 0; ne < 4; ++ne) gq[ne] = *(const f32x4*)(gnp + 16 * ne);
        __builtin_amdgcn_sched_barrier(0);
        float Rb[2][8];
        bf16x8 Qt[2], Qh[2];
#pragma unroll
        for (int kp = 0; kp < 2; ++kp) {
            float qv[8], o1[8], o2[8];
            unpack8(qraw[b][kp], qv);
#pragma unroll
            for (int j = 0; j < 8; ++j) {
                Rb[kp][j] = b > 0 ? sh_row15(cum[b > 0 ? b - 1 : 0][kp][j], lane) : 0.f;
                o1[j] = qv[j] * __builtin_amdgcn_exp2f(cum[b][kp][j] - Rb[kp][j]); o2[j] = qv[j] * __builtin_amdgcn_exp2f(cum[b][kp][j]);
            }
            Qt[kp] = pack8(o1); Qh[kp] = pack8(o2);
        }
        f32x4 O[4];
#pragma unroll
        for (int ne = 0; ne < 4; ++ne) O[ne] = (f32x4){0.f, 0.f, 0.f, 0.f};
#pragma unroll
        for (int ks = 0; ks < KS; ++ks) {
            if (2 * ks <= b) {
                f32x4 sc[2];
#pragma unroll
                for (int hh = 0; hh < 2; ++hh) {
                    const int tt = 2 * ks + hh;
                    sc[hh] = (f32x4){0.f, 0.f, 0.f, 0.f};
                    if (tt <= b) {
#pragma unroll
                        for (int kp = 0; kp < 2; ++kp) {
                            float kc[8], o1[8];
                            unpack8(__builtin_bit_cast(v4u, kcL[(2 * (tt < NT ? tt : 0) + kp) * 64 + lane]), kc);
#pragma unroll
                            for (int j = 0; j < 8; ++j) o1[j] = kc[j] * __builtin_amdgcn_exp2f(fminf(Rb[kp][j] - cum[tt < NT ? tt : 0][kp][j], 115.f));
                            sc[hh] = MFMA16(pack8(o1), Qt[kp], sc[hh]);
                        }
                        if (tt == b) {
#pragma unroll
                            for (int r = 0; r < 4; ++r) if (4 * fq + r > lr) sc[hh][r] = 0.f;
                        }
                    }
                }
                const float pv[8] = {sc[0][0], sc[0][1], sc[0][2], sc[0][3], sc[1][0], sc[1][1], sc[1][2], sc[1][3]};
                const bf16x8 Pf = pack8(pv);
#pragma unroll
                for (int ne = 0; ne < 4; ++ne) O[ne] = MFMA16(tr_frag(vv, 32 * ks, 16 * ne, lane), Pf, O[ne]);
            }
        }
#pragma unroll
        for (int ne = 0; ne < 4; ++ne) { O[ne] = MFMA16(Sf[ne][0], Qh[0], O[ne]); O[ne] = MFMA16(Sf[ne][1], Qh[1], O[ne]); }
        float sq = 0.f;
#pragma unroll
        for (int ne = 0; ne < 4; ++ne)
#pragma unroll
            for (int r = 0; r < 4; ++r) sq += O[ne][r] * O[ne][r];
        sq += shx(sq, 16, lane); sq += shx(sq, 32, lane);
        const float rstd = rsqrtf(sq * (1.f / 64.f) + LN_EPS);
#pragma unroll
        for (int ne = 0; ne < 4; ++ne) {
            const v2u gw = graw[b][ne];
            const float g0 = __uint_as_float(gw.x << 16), g1 = __uint_as_float(gw.x & 0xffff0000u), g2 = __uint_as_float(gw.y << 16), g3 = __uint_as_float(gw.y & 0xffff0000u);
            const float y0 = O[ne][0] * rstd * gq[ne][0] * g0 * sigmoidf_(g0), y1 = O[ne][1] * rstd * gq[ne][1] * g1 * sigmoidf_(g1);
            const float y2 = O[ne][2] * rstd * gq[ne][2] * g2 * sigmoidf_(g2), y3 = O[ne][3] * rstd * gq[ne][3] * g3 * sigmoidf_(g3);
            v2u o; o.x = pk2(y0, y1); o.y = pk2(y2, y3);
            *(v2u*)(ymix + (size_t)t * D + 16 * ne + 4 * fq) = o;
        }
    }
#undef HG_LOADQ
}

#ifndef MIXSEL
#define MIXSEL 7
#endif
#ifndef OLD_RG
#define OLD_RG 0
#endif
#ifndef PROBE_CHASE
#define PROBE_CHASE 0
#endif
#ifndef PROBE_RGREP
#define PROBE_RGREP 1
#endif
template <int PASS> DI void phase_mix(const Args& a, LAS unsigned char* lds, int layer, int sel = 7) {
    const int tid = fresh_tid(), lane = tid & 63, wave = __builtin_amdgcn_readfirstlane(tid >> 6);
    LAS unsigned char* wl = lds + wave * 16384;
    const int w = wave * (int)gridDim.x + fresh_bid();
    if (PASS == 1) {
#if PROBE_CHASE
        {
            const bf16_t* pp = (const bf16_t*)(a.ws + WS_PROJ); size_t idx = ((size_t)w * 6151 + lane * 8) % ((size_t)M * DIN - 64); float accp = 0.f;
#pragma unroll 1
            for (int k = 0; k < PROBE_CHASE; ++k) { const float v = bf2f(pp[idx]); accp += v; idx = (idx * 3 + 12345 + (size_t)(int)(v * 0.f)) % ((size_t)M * DIN - 64); }
            if (accp == 123456.789f) ((float*)(a.ws + WS_LS))[2000] = accp;
        }
#endif
        if (sel & 4) rg_pass1<64>(a, layer, w >> 3, w & 7, lane);
        if (w < 1024) { if (sel & 1) hg_pass1<64>(a, wl, layer, w >> 2, w & 3, lane); }
        else {
            const int s = w - 1024;
            if (sel & 2) ret_pass1<64>(a, wl, s >> 2, s & 3, lane);
            if (s < 128) { if (sel & 4) rg_pass1<32>(a, layer, 256 + (s >> 3), s & 7, lane); }
            else if (s < 192) { if (sel & 1) hg_pass1<32>(a, wl, layer, 256 + ((s - 128) >> 2), (s - 128) & 3, lane); }
            else if (s < 256) { if (sel & 2) ret_pass1<32>(a, wl, 256 + ((s - 192) >> 2), (s - 192) & 3, lane); }
        }
    } else {
        if (w < 1024) {
            if (sel & 1) hg_pass2<64>(a, wl, layer, w >> 2, w & 3, lane);
            if (w < 256) { if (sel & 4) { const int u = 1792 + w; rg_pass2<64>(a, layer, u >> 3, u & 7, lane); } }
            else if (w < 384) { if (sel & 4) { const int u = w - 256; rg_pass2<32>(a, layer, 256 + (u >> 3), u & 7, lane); } }
        } else {
            const int s = w - 1024;
            if (sel & 2) ret_pass2<64>(a, wl, layer, s >> 2, s & 3, lane);
            if (s < 64) { if (sel & 1) hg_pass2<32>(a, wl, layer, 256 + (s >> 2), s & 3, lane); }
            else if (s < 128) { if (sel & 2) ret_pass2<32>(a, wl, layer, 256 + ((s - 64) >> 2), (s - 64) & 3, lane); }
            else if (sel & 4) {
#pragma unroll 1
                for (int k = 0; k < 2; ++k) { const int u = 2 * (s - 128) + k; rg_pass2<64>(a, layer, u >> 3, u & 7, lane); }
            }
        }
    }
}

DI void phase_carry(const Args& a, int layer, int parts = 15) {
    const int gt = fresh_bid() * NTHREADS + fresh_tid(), NT = gridDim.x * NTHREADS;
    const float* CL = (const float*)(a.ws + WS_CL);
    const unsigned* U2 = (const unsigned*)(a.ws + WS_U); unsigned* ST2 = (unsigned*)(a.ws + WS_ST);
    const int gth = (gt >> 9) * 256 + (gt & 255), NTH = NT / 2;
    if ((gt & 256) == 0) {
        if (parts & 2)
        for (int idx = gth; idx < 4 * 8 * 2048; idx += NTH) {
            const int ep = idx & 2047, e = ep >> 5, d = (ep & 31) * 2, kh = (idx >> 11) & 7, q = idx >> 14, kind = kh >> 2, h = kh & 3;
            const float g64 = exp2f(64.f * ret_log2g(h));
            float S0 = 0.f, S1 = 0.f;
#if CARRY_ONE_ROUND
            if (kind == 0) {
                unsigned u[64];
#pragma unroll
                for (int j = 0; j < 64; ++j) { const int ch = q * 64 + j; u[j] = U2[((size_t)ch * 8 + kh) * 2048 + ep]; }
#pragma unroll
                for (int j = 0; j < 64; ++j) { const int ch = q * 64 + j; ST2[((size_t)ch * 8 + kh) * 2048 + ep] = pk2(S0, S1);
                    S0 = g64 * S0 + __uint_as_float(u[j] << 16); S1 = g64 * S1 + __uint_as_float(u[j] & 0xffff0000u); }
            } else {
#pragma unroll 1
                for (int c0 = 0; c0 < 64; c0 += CARRY_HG_CB) {
                    unsigned u[CARRY_HG_CB]; f32x2 dc[CARRY_HG_CB];
#pragma unroll
                    for (int j = 0; j < CARRY_HG_CB; ++j) { const int ch = q * 64 + c0 + j; u[j] = U2[((size_t)ch * 8 + kh) * 2048 + ep]; dc[j] = *(const f32x2*)(CL + (size_t)ch * 256 + h * 64 + d); }
#pragma unroll
                    for (int j = 0; j < CARRY_HG_CB; ++j) { const int ch = q * 64 + c0 + j; ST2[((size_t)ch * 8 + kh) * 2048 + ep] = pk2(S0, S1);
                        const float d0 = __builtin_amdgcn_exp2f(dc[j][0]), d1 = __builtin_amdgcn_exp2f(dc[j][1]);
                        S0 = d0 * S0 + __uint_as_float(u[j] << 16); S1 = d1 * S1 + __uint_as_float(u[j] & 0xffff0000u); }
                }
            }
#else
#pragma unroll 1
            for (int c0 = 0; c0 < 64; c0 += 32) {
                unsigned u[32]; f32x2 dc[32];
#pragma unroll
                for (int j = 0; j < 32; ++j) { const int ch = q * 64 + c0 + j; u[j] = U2[((size_t)ch * 8 + kh) * 2048 + ep]; dc[j] = *(const f32x2*)(CL + (size_t)ch * 256 + h * 64 + d); }
#pragma unroll
                for (int j = 0; j < 32; ++j) { const int ch = q * 64 + c0 + j; ST2[((size_t)ch * 8 + kh) * 2048 + ep] = pk2(S0, S1);
                    const float d0 = __builtin_amdgcn_exp2f(dc[j][0]), d1 = __builtin_amdgcn_exp2f(dc[j][1]);
                    S0 = (kind ? d0 : g64) * S0 + __uint_as_float(u[j] << 16); S1 = (kind ? d1 : g64) * S1 + __uint_as_float(u[j] & 0xffff0000u); }
            }
#endif
            float* so = a.out + (kind ? O_HP : O_TP) + (((size_t)layer * 4 + q) * 4 + h) * 4096 + e;
            so[(size_t)d * 64] = S0; so[(size_t)(d + 1) * 64] = S1;
        }
    } else {
        const float* RGA = (const float*)(a.ws + WS_RGA); const float* RGB = (const float*)(a.ws + WS_RGB); float* HST = (float*)(a.ws + WS_HST);
        if ((parts & 1) && gth < 4 * 512) {
            const int cc = gth & 511, q = gth >> 9; float hh = 0.f;
#pragma unroll 1
            for (int c0 = 0; c0 < 64; c0 += CARRY_RG_CB) {
                float av[CARRY_RG_CB], bv[CARRY_RG_CB];
#pragma unroll
                for (int j = 0; j < CARRY_RG_CB; ++j) { const size_t o = (size_t)(q * 64 + c0 + j) * 512 + cc; av[j] = RGA[o]; bv[j] = RGB[o]; }
#pragma unroll
                for (int j = 0; j < CARRY_RG_CB; ++j) { const size_t o = (size_t)(q * 64 + c0 + j) * 512 + cc; HST[o] = hh; hh = av[j] * hh + bv[j]; }
            }
            a.out[O_RP + ((size_t)layer * 4 + q) * 512 + cc] = hh;
        } else if (gth >= 4096) {
            const int g2 = gth - 4096, NT2 = NTH - 4096;
            if (parts & 1)
            for (int idx = g2; idx < 16 * 512; idx += NT2) {
                const int cc = idx & 511, b = idx >> 9; const size_t o = (size_t)(256 + b) * 512 + cc;
                const float h0 = a.in[3][((size_t)layer * 16 + b) * 512 + cc];
                HST[o] = h0; a.out[O_RS + ((size_t)layer * 16 + b) * 512 + cc] = RGA[o] * h0 + RGB[o];
            }
            if (parts & 4)
            for (int idx = g2; idx < 16 * 8 * 2048; idx += NT2) {
                const int ep = idx & 2047, e = ep >> 5, d = (ep & 31) * 2, kh = (idx >> 11) & 7, b = idx >> 14, kind = kh >> 2, h = kh & 3, ch = 256 + b;
                const float* sin_ = a.in[kind ? 5 : 4] + (((size_t)layer * 16 + b) * 4 + h) * 4096 + e;
                const float S0 = sin_[(size_t)d * 64], S1 = sin_[(size_t)(d + 1) * 64];
                const f32x2 cl = *(const f32x2*)(CL + (size_t)ch * 256 + h * 64 + d);
                const float g32 = exp2f(32.f * ret_log2g(h));
                const float dec0 = kind ? __builtin_amdgcn_exp2f(cl[0]) : g32, dec1 = kind ? __builtin_amdgcn_exp2f(cl[1]) : g32;
                const unsigned u = U2[((size_t)ch * 8 + kh) * 2048 + ep];
                ST2[((size_t)ch * 8 + kh) * 2048 + ep] = pk2(S0, S1);
                float* so = a.out + (kind ? O_HS : O_TS) + (((size_t)layer * 16 + b) * 4 + h) * 4096 + e;
                so[(size_t)d * 64] = dec0 * S0 + __uint_as_float(u << 16); so[(size_t)(d + 1) * 64] = dec1 * S1 + __uint_as_float(u & 0xffff0000u);
            }
            const bf16_t* proj = (const bf16_t*)(a.ws + WS_PROJ);
            if (parts & 8)
            for (int idx = g2; idx < NSEQ * 3 * 512; idx += NT2) {
                const int cc = idx & 511, j = (idx >> 9) % 3, q = idx / (3 * 512);
                const float v = bf2f(proj[(size_t)(seq_row0(q) + seq_len(q) - 3 + j) * DIN + C_RGX + cc]);
                if (q < NB) a.out[O_CP + (((size_t)layer * 4 + q) * 3 + j) * 512 + cc] = v; else a.out[O_CS + (((size_t)layer * 16 + (q - NB)) * 3 + j) * 512 + cc] = v;
            }
        }
    }
}

DI void phase_tables(const Args& a) {
    const int gt = fresh_bid() * NTHREADS + fresh_tid(), NT = gridDim.x * NTHREADS;
#if STATS_FUSED
    { v4u ones; ones.x = ones.y = ones.z = ones.w = ~0u; v4u* xs = (v4u*)(a.ws + WS_XBUF);
      for (int idx = gt; idx < (int)(2 * XBUF_LAYER / 16); idx += NT) xs[idx] = ones; }
#endif
    float* rcos = (float*)(a.ws + WS_ROPE); float* rsin = rcos + 4096 * 32;
    for (int idx = gt; idx < 4096 * 32; idx += NT) {
        const int pos = idx >> 5, i = idx & 31;
        const float inv = exp2f(-(float)i * (13.287712379549449f / 32.f));
        float sn, cs; sincosf((float)pos * inv, &sn, &cs);
        rcos[idx] = cs; rsin[idx] = sn;
    }
    for (int idx = gt; idx < 2 * 512; idx += NT) ((float*)(a.ws + WS_LS))[idx] = -16.f * log1pf(__expf(-a.in[13][idx]));
    for (int idx = gt; idx < 2 * 256; idx += NT) { const int l = idx >> 8, j = idx & 255; ((float*)(a.ws + WS_LBT))[idx] = l ? 1.f / (1.f + __expf(a.in[16][j] - a.in[16][256 + j])) : 0.f; }
    bf16_t* gwt = (bf16_t*)(a.ws + WS_GATEW);
    for (int idx = gt; idx < 2 * 2 * 8 * 4096; idx += NT) {
        const int cin = idx & 63, cc = (idx >> 6) & 63, g = (idx >> 12) & 7, which = (idx >> 15) & 1, l = idx >> 16;
        gwt[idx] = f2bf(-1.4426950408889634f * a.in[which ? 11 : 9][(((size_t)l * 8 + g) * 64 + cin) * 64 + cc]);
    }
}
#ifndef ONE_LAUNCH
#define ONE_LAUNCH 1
#endif
#if !ONE_LAUNCH
template <int PH> __global__ void __launch_bounds__(NTHREADS, 2) k_ph(Args a) {
    extern __shared__ __attribute__((aligned(16))) unsigned char lds_raw[];
    LAS unsigned char* lds = (LAS unsigned char*)lds_raw;
    park_wave_index();
    __syncthreads();
    if (PH == 0) { phase_prologue(a, lds); phase_tables(a); }
    else if (PH == 1) phase_gemm_in(a, lds, a.layer);
    else if (PH == 2) phase_mix<1>(a, lds, a.layer);
    else if (PH == 3) phase_carry(a, a.layer);
    else if (PH == 4) phase_mix<2>(a, lds, a.layer);
    else if (PH == 5) phase_gemm_out(a, lds, a.layer);
    else if (PH == 6) phase_sample_final_ln(a);
}
template <int PH> static void launch_ph(int grid, hipStream_t stream, const Args& a) {
    static bool attr = false;
    if (!attr) { (void)hipFuncSetAttribute((const void*)k_ph<PH>, hipFuncAttributeMaxDynamicSharedMemorySize, LDS_BYTES); attr = true; }
    hipLaunchKernelGGL(k_ph<PH>, dim3(grid), dim3(NTHREADS), LDS_BYTES, stream, a);
}

#endif
#ifndef PROBE_DUP
#define PROBE_DUP 0
#endif
#ifndef PROBE_TIME
#define PROBE_TIME -1
#endif
#if PROBE_TIME >= 0
#ifndef PROBE_TIME_B
#define PROBE_TIME_B (PROBE_TIME + 1)
#endif
#define PSTAMP(k_) do { if (fresh_bid() == 0 && fresh_tid() == 0) { const unsigned long long t_ = __builtin_amdgcn_s_memrealtime(); volatile LAS unsigned* ms_ = (volatile LAS unsigned*)(lds + MISC_OFF + 512); ms_[2 * (k_)] = (unsigned)t_; ms_[1 + 2 * (k_)] = (unsigned)(t_ >> 32); } } while (0)
#define PTIME_READOUT() do { if (fresh_bid() == 0) { __syncthreads(); volatile LAS unsigned* ms_ = (volatile LAS unsigned*)(lds + MISC_OFF + 512); \
        const unsigned long long t0_ = ((unsigned long long)ms_[1 + 2 * PROBE_TIME] << 32) | ms_[2 * PROBE_TIME], t1_ = ((unsigned long long)ms_[1 + 2 * (PROBE_TIME_B)] << 32) | ms_[2 * (PROBE_TIME_B)]; \
        const float sc_ = 1.f + (float)(t1_ - t0_) * 1e-5f; \
        for (int i_ = fresh_tid(); i_ < 2 * 16 * 3 * 512; i_ += NTHREADS) a.out[O_CS + i_] *= sc_; } } while (0)
#else
#define PSTAMP(k_) do { } while (0)
#define PTIME_READOUT() do { } while (0)
#endif
__global__ void __launch_bounds__(NTHREADS, 2) mega(Args a) {
    extern __shared__ __attribute__((aligned(16))) unsigned char lds_raw[];
    LAS unsigned char* lds = (LAS unsigned char*)lds_raw;
    volatile LAS unsigned* misc = (volatile LAS unsigned*)(lds + MISC_OFF);
    if (threadIdx.x < 32) misc[threadIdx.x] = 0u;
    park_wave_index();
    __syncthreads();
    (void)xcd_barrier_post((unsigned*)(a.ws + WS_CTL) + CW_BAR, misc + 8);
    PSTAMP(0);
    phase_prologue(a, lds); phase_tables(a);
    grid_barrier(a, lds);
    PSTAMP(1);
    if (PROBE_DUP == 6) { phase_prologue(a, lds); phase_tables(a); grid_barrier(a, lds); }
    if (PROBE_DUP == 20) {
#pragma unroll 1
        for (int i = 0; i < 20; ++i) grid_barrier(a, lds);
    }
#pragma unroll 1
    for (int layer = 0; layer < DEPTH; ++layer) {
        phase_gemm_in(a, lds, layer);
        grid_barrier(a, lds);
        PSTAMP(2 + 5 * layer);
        if (PROBE_DUP == 1) { phase_gemm_in(a, lds, layer); grid_barrier(a, lds); }
        phase_mix<1>(a, lds, layer);
        grid_barrier(a, lds);
        PSTAMP(3 + 5 * layer);
        if (PROBE_DUP == 2) { phase_mix<1>(a, lds, layer); grid_barrier(a, lds); }
        if (PROBE_DUP >= 7 && PROBE_DUP <= 9) { phase_mix<1>(a, lds, layer, 1 << (PROBE_DUP - 7)); grid_barrier(a, lds); }
        phase_carry(a, layer);
        grid_barrier(a, lds);
        PSTAMP(4 + 5 * layer);
        if (PROBE_DUP == 3) { phase_carry(a, layer); grid_barrier(a, lds); }
        if (PROBE_DUP >= 30 && PROBE_DUP < 46) { phase_carry(a, layer, PROBE_DUP - 30); grid_barrier(a, lds); }
        phase_mix<2>(a, lds, layer);
        grid_barrier(a, lds);
        PSTAMP(5 + 5 * layer);
        if (PROBE_DUP == 4) { phase_mix<2>(a, lds, layer); grid_barrier(a, lds); }
        if (PROBE_DUP >= 10 && PROBE_DUP <= 12) { phase_mix<2>(a, lds, layer, 1 << (PROBE_DUP - 10)); grid_barrier(a, lds); }
        phase_gemm_out(a, lds, layer);
        if (PROBE_DUP == 5) { grid_barrier(a, lds); phase_gemm_out(a, lds, layer); }
#if FINAL_LN_INLINE
        if (layer + 1 < DEPTH) grid_barrier(a, lds);
        PSTAMP(6 + 5 * layer);
    }
    PTIME_READOUT();
#else
        grid_barrier(a, lds);
    }
    phase_sample_final_ln(a);
#endif
}

#ifndef ONE_LAUNCH
#define ONE_LAUNCH 1
#endif
#ifndef NAIVE_RG
#define NAIVE_RG 0
#endif
#ifndef NAIVE_RET
#define NAIVE_RET 0
#endif
#ifndef NAIVE_HG
#define NAIVE_HG 0
#endif

extern "C" void kernel_launch(void* const* d_in, const int* in_sizes, int n_in, void* d_out, int out_size, void* d_ws, size_t ws_size, hipStream_t stream) {
    static int grid = 0;
    if (grid == 0) {
        int dev = 0, cus = 0;
        (void)hipGetDevice(&dev); (void)hipDeviceGetAttribute(&cus, hipDeviceAttributeMultiprocessorCount, dev);
        int per_cu = 0;
        (void)hipFuncSetAttribute((const void*)mega, hipFuncAttributeMaxDynamicSharedMemorySize, LDS_BYTES);
        if (hipOccupancyMaxActiveBlocksPerMultiprocessor(&per_cu, (const void*)mega, NTHREADS, LDS_BYTES) != hipSuccess || per_cu < 1)
            fprintf(stderr, "kernel_launch: occupancy query reports %d workgroups per CU for the megakernel\n", per_cu);
        (void)hipGetLastError();
        grid = cus;
        if (n_in != 21 || out_size != (int)O_END || ws_size < WS_END) fprintf(stderr, "kernel_launch: unexpected sizes n_in %d out %d ws %zu\n", n_in, out_size, ws_size);
    }
    const float* const* in = (const float* const*)d_in;
    unsigned char* ws = (unsigned char*)d_ws;
    float* out = (float*)d_out;
    (void)hipMemsetAsync(ws + WS_CTL, 0, CTL_ZERO_BYTES, stream);
#if defined(PROBE_MEMSET2)
    for (int i_ = 0; i_ < PROBE_MEMSET2; ++i_) (void)hipMemsetAsync(ws + WS_CTL, 0, CTL_ZERO_BYTES, stream);
#endif
    Args a{};
    for (int i = 0; i < 21; ++i) a.in[i] = in[i];
    a.out = out; a.ws = ws;
    bf16_t* PROJ = (bf16_t*)(ws + WS_PROJ); bf16_t* YMIX = (bf16_t*)(ws + WS_YMIX);
    (void)PROJ; (void)YMIX;
#if ONE_LAUNCH
    hipLaunchKernelGGL(mega, dim3(grid), dim3(NTHREADS), LDS_BYTES, stream, a);
#endif
#if !ONE_LAUNCH
    a.phase = 0; a.layer = 0;
    launch_ph<0>(grid, stream, a);
    for (int l = 0; l < DEPTH; ++l) {
        a.layer = l;
        launch_ph<1>(grid, stream, a); launch_ph<2>(grid, stream, a); launch_ph<3>(grid, stream, a); launch_ph<4>(grid, stream, a);
#if NAIVE_RG
        k_rg_naive<<<NSEQ * 8, 64, 0, stream>>>(PROJ, YMIX, in[2] + (size_t)l * 16 * 3 * 512, in[3] + (size_t)l * 16 * 512, in[7] + l * 4 * 512, in[8] + l * 512,
                                                in[9] + (size_t)l * 8 * 64 * 64, in[10] + l * 512, in[11] + (size_t)l * 8 * 64 * 64, in[12] + l * 512, in[13] + l * 512, out, l);
#endif
#if NAIVE_RET
        k_lin_naive<false><<<NSEQ * 4, 256, 0, stream>>>(PROJ, YMIX, in[4] + (size_t)l * 16 * 4 * 4096, in[14] + l * 256, nullptr, nullptr, out, l);
#endif
#if NAIVE_HG
        k_lin_naive<true><<<NSEQ * 4, 256, 0, stream>>>(PROJ, YMIX, in[5] + (size_t)l * 16 * 4 * 4096, in[17] + l * 256, in[15] + l * 256, in[16], out, l);
#endif
        launch_ph<5>(grid, stream, a);
    }
    launch_ph<6>(grid, stream, a);
#endif
}
```

```cpp
#include <hip/hip_runtime.h>
#include <cstdio>
#include <cstdint>

typedef unsigned short bf16_t;
constexpr int D = 1024, NB = 4, SEQ = 4096, DEPTH = 2, DB = 16, DS = 32, PAST = 1024;
constexpr int MP = NB * SEQ, MS = DB * DS, M = MP + MS;
constexpr int DIN = 3072, NSEQ = NB + DB;
constexpr int C_RGX = 0, C_RGG = 512, C_RQ = 1024, C_RK = 1280, C_RV = 1536, C_RG = 1792, C_HQ = 2048, C_HF = 2304, C_HI = 2560, C_HG = 2816;
constexpr size_t O_YP = 0, O_YS = O_YP + (size_t)MP * D, O_CP = O_YS + (size_t)MS * D, O_RP = O_CP + 2 * 4 * 3 * 512, O_TP = O_RP + 2 * 4 * 512,
                 O_HP = O_TP + 2 * 4 * 4 * 4096, O_CS = O_HP + 2 * 4 * 4 * 4096, O_RS = O_CS + 2 * 16 * 3 * 512, O_TS = O_RS + 2 * 16 * 512,
                 O_HS = O_TS + 2 * 16 * 4 * 4096, O_END = O_HS + 2 * 16 * 4 * 4096;
static_assert(O_END == 18694144, "output size");
#ifndef PANEL_SEAM
#define PANEL_SEAM 1
#endif
#ifndef PG8_WGM
#define PG8_WGM 8
#endif
#ifndef MIX_IGLP
#define MIX_IGLP -1
#endif
#ifndef FINAL_LN_INLINE
#define FINAL_LN_INLINE 1
#endif
#ifndef GIN_ALIGN
#define GIN_ALIGN true
#endif
#ifndef GIN_SP2
#define GIN_SP2 true
#endif
#ifndef PROBE_MFMA
#define PROBE_MFMA 0
#endif
#ifndef PROBE_PK
#define PROBE_PK 0
#endif
#ifndef PROBE_STORE2
#define PROBE_STORE2 0
#endif
#ifndef PROBE_VALU
#define PROBE_VALU 0
#endif
constexpr float LN_EPS = 1e-5f, F_EPS = 1e-6f;
constexpr float DN_ALPHA = 1.41421356237309515f;

constexpr size_t MiB = 1u << 20;
constexpr size_t WS_CTL = 0, CTL_ZERO_BYTES = 1 * MiB;
constexpr size_t WS_XBUF = 1 * MiB;
constexpr size_t XBUF_LAYER = (size_t)M * 4 * 8;
constexpr size_t WS_XN = 4 * MiB;
constexpr size_t WS_PROJ = 37 * MiB;
constexpr size_t WS_YMIX = 136 * MiB;
constexpr size_t WS_ST = 170 * MiB;
constexpr size_t WS_P = 187 * MiB;
constexpr size_t WS_HL = 204 * MiB;
constexpr size_t WS_YPRE = 221 * MiB;
constexpr size_t WS_X1S = 224 * MiB;
constexpr size_t WS_WIN = 236 * MiB;
constexpr size_t WS_WOUT = 248 * MiB;
constexpr size_t WS_MISC = 252 * MiB;
constexpr size_t WS_END = 256 * MiB;
static_assert(WS_XBUF + 2 * XBUF_LAYER <= WS_XN && WS_XN + (size_t)M * D * 2 <= WS_PROJ && WS_PROJ + (size_t)M * DIN * 2 <= WS_YMIX && WS_P + (size_t)M * 512 * 2 <= WS_HL && WS_HL + (size_t)M * 512 * 2 <= WS_WIN, "ws map");
constexpr int CW_TMO = 0, CW_CODE = 1, CW_BAR = 4096, CW_SEAM = 16384, SEAM_BANK = 128 * 64, CW_SAMP = 40960, CW_PDONE = 49152;
static_assert((size_t)(CW_SEAM + 2 * SEAM_BANK) * 4 <= CTL_ZERO_BYTES, "control words inside the per-call memset");

__device__ __forceinline__ float bf2f(bf16_t v) { return __uint_as_float((unsigned)v << 16); }
__device__ __forceinline__ bf16_t f2bf(float f) { unsigned u = __float_as_uint(f); return (bf16_t)((u + 0x7fffu + ((u >> 16) & 1u)) >> 16); }
typedef float f32x2_t __attribute__((ext_vector_type(2)));
typedef __bf16 bf16x2_t __attribute__((ext_vector_type(2)));
__device__ __forceinline__ unsigned pk2(float lo, float hi) { const f32x2_t v = {lo, hi}; return __builtin_bit_cast(unsigned, __builtin_convertvector(v, bf16x2_t)); }
__device__ __forceinline__ float frcp(float x) { return __builtin_amdgcn_rcpf(x); }
__device__ __forceinline__ float fexp(float x) { return __builtin_amdgcn_exp2f(x * 1.4426950408889634f); }
__device__ __forceinline__ float sigmoidf_(float x) { return frcp(1.f + fexp(-x)); }
__host__ __device__ inline int seq_row0(int q) { return q < NB ? q * SEQ : MP + (q - NB) * DS; }
__host__ __device__ inline int seq_len(int q) { return q < NB ? SEQ : DS; }
__device__ __forceinline__ float shx(float v, int mask, int lane) { return __builtin_bit_cast(float, __builtin_amdgcn_ds_bpermute((lane ^ mask) << 2, __builtin_bit_cast(int, v))); }
__device__ __forceinline__ float sh_row15(float v, int lane) { return __builtin_bit_cast(float, __builtin_amdgcn_ds_bpermute((lane | 15) << 2, __builtin_bit_cast(int, v))); }
__device__ __forceinline__ float wave_sum(float v, int lane) {
#pragma unroll
    for (int o = 1; o < 64; o <<= 1) v += shx(v, o, lane);
    return v;
}
#ifndef BAR_SHORT
#define BAR_SHORT 1
#endif
#ifndef RES_PREFETCH
#define RES_PREFETCH 0
#endif
#ifndef SAMPLE_OUT_KSLICE
#define SAMPLE_OUT_KSLICE 1
#endif
#ifndef SAMPLE_IN_KSLICE
#define SAMPLE_IN_KSLICE 1
#endif
#ifndef CARRY_ONE_ROUND
#define CARRY_ONE_ROUND 1
#endif
#ifndef CARRY_RG_CB
#define CARRY_RG_CB 32
#endif
#ifndef CARRY_HG_CB
#define CARRY_HG_CB 32
#endif
#ifndef STATS_FUSED
#define STATS_FUSED 1
#endif
#ifndef GIN_DEPHASE
#define GIN_DEPHASE 1
#endif
#ifndef SG_XPOSE
#define SG_XPOSE 1
#endif
#ifndef EPI_XPOSE
#define EPI_XPOSE 1
#endif
#ifndef RG_STAGE
#define RG_STAGE 1
#endif
#ifndef RG_STORE_XPOSE
#define RG_STORE_XPOSE 1
#endif
#ifndef UT_XPOSE
#define UT_XPOSE 1
#endif
#ifndef FRAG_PERM
#define FRAG_PERM 1
#endif
#ifndef FRAG_PERM2
#define FRAG_PERM2 0
#endif
#ifndef OUT_NT
#define OUT_NT 1
#endif
#ifndef PROJ_NT
#define PROJ_NT 0
#endif
#ifndef X_NT
#define X_NT 1
#endif
#ifndef LAST_USE_NT
#define LAST_USE_NT 1
#endif
#if LAST_USE_NT
#define LAST_USE_LD(p_) __builtin_nontemporal_load(p_)
#else
#define LAST_USE_LD(p_) (*(p_))
#endif
#ifndef MIX2_REBALANCE
#define MIX2_REBALANCE 0
#endif
#ifndef FRAG_PERM3
#define FRAG_PERM3 0
#endif
#ifndef MIX1_DEPHASE
#define MIX1_DEPHASE 2
#endif
#ifndef MIX2_DEPHASE
#define MIX2_DEPHASE 2
#endif
#ifndef MIX1_DEPHASE_SHIFT
#define MIX1_DEPHASE_SHIFT 3
#endif
#ifndef X_COALESCED
#define X_COALESCED 0
#endif
#ifndef GIN_DEPHASE_SHIFT
#define GIN_DEPHASE_SHIFT 3
#endif
#ifndef CARRY_SAMPLE_BATCH
#define CARRY_SAMPLE_BATCH 0
#endif
#ifndef PRO_DEPHASE
#define PRO_DEPHASE 0
#endif
#ifndef LN_TAIL_FAST
#define LN_TAIL_FAST 1
#endif
#ifndef BAR_TIGHT
#define BAR_TIGHT 0
#endif
#define X_COALESCED 1
namespace pg8 {
#define PG8_LAS __attribute__((address_space(3)))
typedef unsigned short bf16_t;
typedef short bf16x8 __attribute__((ext_vector_type(8)));
typedef float f32x4 __attribute__((ext_vector_type(4)));
typedef unsigned u32x4 __attribute__((ext_vector_type(4)));
constexpr int BM = 256, BK = 64, HALF = 128, HTB = HALF * BK * 2  , STAGE_BYTES = 8 * HTB, NXCD = 8, WGM = PG8_WGM;

__host__ __device__ __forceinline__ int lds_byte(int r, int c) { const int st = (r >> 4) * 2 + (c >> 5), rr = r & 15, cc = c & 31, ob = rr * 64 + cc * 2; return st * 1024 + (ob ^ (((ob >> 9) & 1) << 5)); }
__host__ __device__ __forceinline__ void stage_rc(int b, int& R, int& C) { const int st = b / 1024, sb = b % 1024, swz = sb ^ (((sb >> 9) & 1) << 5); R = (st >> 1) * 16 + swz / 64; C = (st & 1) * 32 + (swz % 64) / 2; }
__host__ __device__ __forceinline__ int perm32(int rho) { const int n = rho >> 4, i = rho & 15; return 8 * (i >> 2) + 4 * n + (i & 3); }

struct Unit { int pm, pn; };
struct Gemm { const bf16_t* A; const bf16_t* Bt; int M, N, K; };

struct StaticOrder {
    int nM, nN, nwg, G, c;
    __host__ __device__ void init(int M, int N, int G_, int c_) { nM = M / BM; nN = N / BM; nwg = nM * nN; G = G_; c = c_; }
    __host__ __device__ bool next(int i, Unit& u) const {
        const long L = (long)i * G + c; if (L >= nwg) return false;
        int wgid = (int)L; { const int q = nwg / NXCD, r = nwg % NXCD, xcd = wgid % NXCD, off = wgid / NXCD; wgid = (xcd < r ? xcd * (q + 1) : r * (q + 1) + (xcd - r) * q) + off; }
        const int nig = WGM * nN, gid = wgid / nig, fm = gid * WGM, gsz = (nM - fm) < WGM ? (nM - fm) : WGM;
        u.pm = fm + ((wgid % nig) % gsz); u.pn = (wgid % nig) / gsz; return true;
    }
    __device__ __forceinline__ void a_ready(const Unit&) const {}
    __device__ __forceinline__ void done(const Unit&) const {}
};

__device__ __forceinline__ unsigned cvt_pk_bf16(float lo, float hi) { unsigned r; asm volatile("v_cvt_pk_bf16_f32 %0, %1, %2" : "=v"(r) : "v"(lo), "v"(hi)); return r; }
typedef float f32x2 __attribute__((ext_vector_type(2)));
__device__ __forceinline__ f32x2 gelu_pk(f32x2 v) {
    const f32x2 av = __builtin_elementwise_abs(v), d = av * 0.2316418882f + 1.0f;
    f32x2 t; t.x = __builtin_amdgcn_rcpf(d.x); t.y = __builtin_amdgcn_rcpf(d.y);
    f32x2 q = t * 0.5307027145f + (-0.7265760135f); q = q * t + 0.7107068705f; q = q * t + (-0.142248368f); q = q * t + 0.127414796f; q = q * t;
    const f32x2 s = (v * v) * (-0.72134752044f);
    f32x2 e; e.x = __builtin_amdgcn_exp2f(s.x); e.y = __builtin_amdgcn_exp2f(s.y);
    const f32x2 m = v * (q * e), r = v - m;
    f32x2 o; o.x = v.x < 0.f ? m.x : r.x; o.y = v.y < 0.f ? m.y : r.y; return o;
}

template <int ACT  > struct EpiBf16 {
    static constexpr bool PERM = true, AFTER_DRAIN = false; static_assert(ACT == 0 || ACT == 1, "EpiBf16: ACT is 0 (none) or 1 (gelu_pk)");
    bf16_t* O; int ldc; const float* bias; int split_cols; size_t split_stride; float scale0;
    __device__ __forceinline__ void operator()(const f32x4 (&acc)[2][2][4][2], const Unit& u, int wr, int wc, int fr, int fq) const {
        const int row0 = u.pm * BM + wr * 64 + fr; int colt = u.pn * BM; bf16_t* base = O;
        float sc = 1.f; if (split_cols) { const int t = colt / split_cols; base += (size_t)t * split_stride; colt -= t * split_cols; if (t == 0) sc = scale0; }
#if EPI_XPOSE
        extern __shared__ __attribute__((aligned(16))) unsigned char lds_epi_[];
        const int lane_ = fr + 16 * fq;
        PG8_LAS unsigned char* slot = (PG8_LAS unsigned char*)lds_epi_ + 136192 + (wr * 4 + wc) * 1280;
        const int wofs = 80 * fr + 16 * fq, rofs = 80 * (lane_ >> 2) + 16 * (lane_ & 3);
        const int row0s = u.pm * BM + wr * 64 + (lane_ >> 2), col0s = colt + wc * 32 + 8 * (lane_ & 3);
#endif
        const int col0 = colt + wc * 32 + 8 * fq, bcol0 = u.pn * BM + wc * 32 + 8 * fq;
        f32x4 bv[2][2];
#pragma unroll
        for (int bj = 0; bj < 2; ++bj)
#pragma unroll
            for (int n = 0; n < 2; ++n) bv[bj][n] = bias ? *(const f32x4*)(bias + bcol0 + bj * HALF + 4 * n) : (f32x4){0.f, 0.f, 0.f, 0.f};
#pragma unroll
        for (int ai = 0; ai < 2; ++ai)
#pragma unroll
            for (int m = 0; m < 4; ++m) { bf16_t* rowp = base + (size_t)(row0 + ai * HALF + m * 16) * ldc + col0;
#pragma unroll
                for (int bj = 0; bj < 2; ++bj) { f32x4 v0 = acc[ai][bj][m][0] + bv[bj][0], v1 = acc[ai][bj][m][1] + bv[bj][1];
                    if (ACT == 1) { f32x2 a = gelu_pk((f32x2){v0[0], v0[1]}), b = gelu_pk((f32x2){v0[2], v0[3]}), c = gelu_pk((f32x2){v1[0], v1[1]}), d = gelu_pk((f32x2){v1[2], v1[3]});
                        v0 = (f32x4){a.x, a.y, b.x, b.y}; v1 = (f32x4){c.x, c.y, d.x, d.y}; }
                    v0 = v0 * sc; v1 = v1 * sc; u32x4 w; w.x = cvt_pk_bf16(v0[0], v0[1]); w.y = cvt_pk_bf16(v0[2], v0[3]); w.z = cvt_pk_bf16(v1[0], v1[1]); w.w = cvt_pk_bf16(v1[2], v1[3]);
#if EPI_XPOSE
                    *(PG8_LAS u32x4*)(slot + wofs) = w; const u32x4 wt = *(const PG8_LAS u32x4*)(slot + rofs);
#if PROJ_NT
                    __builtin_nontemporal_store(wt, (u32x4*)(base + (size_t)(row0s + ai * HALF + m * 16) * ldc + col0s + bj * HALF)); } }
#else
                    *(u32x4*)(base + (size_t)(row0s + ai * HALF + m * 16) * ldc + col0s + bj * HALF) = wt; } }
#endif
#else
                    *(u32x4*)(rowp + bj * HALF) = w; } }
#endif
    }
};

struct PanelStats {
    unsigned* xbuf;
    unsigned* cnt;
    unsigned* tmo;
    int ntn; float eps;
    unsigned code;
    unsigned* pub = nullptr;
    __device__ __forceinline__ bool run(const f32x4 (&v)[2][2][4][2], const Unit& u, int wr, int wc, int fr, int fq, PG8_LAS unsigned char* lds, int wid, int lane) const {
        typedef float f32x2v __attribute__((ext_vector_type(2)));
        PG8_LAS f32x2v* P = (PG8_LAS f32x2v*)lds;
        PG8_LAS f32x2v* S = (PG8_LAS f32x2v*)(lds + 8192);
        PG8_LAS unsigned* flag = (PG8_LAS unsigned*)(lds + 8192 + 2048);
#pragma unroll
        for (int ai = 0; ai < 2; ++ai)
#pragma unroll
            for (int m = 0; m < 4; ++m) {
                float s = 0.f;
#pragma unroll
                for (int bj = 0; bj < 2; ++bj)
#pragma unroll
                    for (int n = 0; n < 2; ++n) { const f32x4 x = v[ai][bj][m][n]; s += (x[0] + x[1]) + (x[2] + x[3]); }
                s += shx(s, 16, lane); s += shx(s, 32, lane);
                const float mw = s * (1.0f / 64.0f); float q = 0.f;
#pragma unroll
                for (int bj = 0; bj < 2; ++bj)
#pragma unroll
                    for (int n = 0; n < 2; ++n) { const f32x4 d = v[ai][bj][m][n] - mw; q += (d[0] * d[0] + d[1] * d[1]) + (d[2] * d[2] + d[3] * d[3]); }
                q += shx(q, 16, lane); q += shx(q, 32, lane);
                if (fq == 0) P[(ai * HALF + wr * 64 + m * 16 + fr) * 4 + wc] = (f32x2v){mw, q};
            }
        asm volatile("s_waitcnt lgkmcnt(0)" ::: "memory"); __builtin_amdgcn_s_barrier(); asm volatile("" ::: "memory");
#if STATS_FUSED
        const int row = wid * 32 + (lane & 31);
        unsigned long long* slot = (unsigned long long*)xbuf + (size_t)(u.pm * BM + row) * 4;
        if (lane < 32) {
            const f32x2v a = P[row * 4 + 0], b = P[row * 4 + 1], c = P[row * 4 + 2], d = P[row * 4 + 3];
            const float mt = (a.x + b.x + c.x + d.x) * 0.25f;
            const float da = a.x - mt, db = b.x - mt, dc = c.x - mt, dd = d.x - mt;
            const float m2 = (a.y + b.y) + (c.y + d.y) + 64.0f * ((da * da + db * db) + (dc * dc + dd * dd));
            __hip_atomic_store(slot + u.pn, ((unsigned long long)__float_as_uint(m2) << 32) | __float_as_uint(mt), __ATOMIC_RELAXED, __HIP_MEMORY_SCOPE_AGENT);
        }
        if (pub && wid == 7 && lane == 32) { __builtin_amdgcn_fence(__ATOMIC_RELEASE, "agent"); asm volatile("s_waitcnt vmcnt(0)" ::: "memory"); __hip_atomic_fetch_add(pub, 1u, __ATOMIC_RELAXED, __HIP_MEMORY_SCOPE_AGENT); }
        if (lane < 32) {
            unsigned long long w[4]; unsigned sp = 0u;
            for (;;) {
                bool all = true;
#pragma unroll
                for (int t = 0; t < 4; ++t) { w[t] = t < ntn ? __hip_atomic_load(slot + t, __ATOMIC_RELAXED, __HIP_MEMORY_SCOPE_AGENT) : 0ull; all = all && (w[t] != ~0ull); }
                if (all || ++sp > (1u << 18)) break;
                __builtin_amdgcn_s_sleep(1);
            }
            float mt[4], m2[4]; float ms = 0.f;
#pragma unroll
            for (int t = 0; t < 4; ++t) { mt[t] = t < ntn ? __uint_as_float((unsigned)w[t]) : 0.f; m2[t] = t < ntn ? __uint_as_float((unsigned)(w[t] >> 32)) : 0.f; ms += mt[t]; }
            const float mean = ms / (float)ntn; float q = 0.f;
#pragma unroll
            for (int t = 0; t < 4; ++t) if (t < ntn) { const float dm = mt[t] - mean; q += m2[t] + 256.0f * dm * dm; }
            S[row] = (f32x2v){mean, 1.0f / sqrtf(q / (256.0f * (float)ntn) + eps)};
        }
        asm volatile("s_waitcnt vmcnt(0) lgkmcnt(0)" ::: "memory"); __builtin_amdgcn_s_barrier(); asm volatile("" ::: "memory");
        (void)flag;
        return false;
#else
#if defined(BROKEN_EXCHANGE_NO_WAIT)
#warning BROKEN CONTROL BUILD: the row-statistics exchange does not wait; results are wrong by design
        if (blockIdx.x >= 64) { const long long t0_ = clock64(); while (clock64() - t0_ < 60000) __builtin_amdgcn_s_sleep(8); }
#endif
        const int row = wid * 32 + (lane & 31);
        if (lane < 32) {
            const f32x2v a = P[row * 4 + 0], b = P[row * 4 + 1], c = P[row * 4 + 2], d = P[row * 4 + 3];
            const float mt = (a.x + b.x + c.x + d.x) * 0.25f;
            const float da = a.x - mt, db = b.x - mt, dc = c.x - mt, dd = d.x - mt;
            const float m2 = (a.y + b.y) + (c.y + d.y) + 64.0f * ((da * da + db * db) + (dc * dc + dd * dd));
            unsigned long long* slot = (unsigned long long*)xbuf + ((size_t)(u.pm * BM + row) * 4 + u.pn);
            __hip_atomic_store(slot, ((unsigned long long)__float_as_uint(m2) << 32) | __float_as_uint(mt), __ATOMIC_RELAXED, __HIP_MEMORY_SCOPE_AGENT);
        }
        asm volatile("s_waitcnt vmcnt(0)" ::: "memory");
        if (lane == 0) __hip_atomic_fetch_add(cnt + 64 * u.pm, 1u, __ATOMIC_RELAXED, __HIP_MEMORY_SCOPE_AGENT);
        if (pub && wid == 7 && lane == 0) { __builtin_amdgcn_fence(__ATOMIC_RELEASE, "agent"); asm volatile("s_waitcnt vmcnt(0)" ::: "memory"); __hip_atomic_fetch_add(pub, 1u, __ATOMIC_RELAXED, __HIP_MEMORY_SCOPE_AGENT); }
        if (wid == 0) {
            bool dead = false; const unsigned long long t0 = __builtin_amdgcn_s_memrealtime(); const unsigned want = 8u * (unsigned)ntn;
            for (;;) {
#if defined(BROKEN_EXCHANGE_NO_WAIT)
                break;
#endif
                if ((unsigned)__builtin_amdgcn_readfirstlane(__hip_atomic_load(cnt + 64 * u.pm, __ATOMIC_RELAXED, __HIP_MEMORY_SCOPE_AGENT)) >= want) break;
                if (__builtin_amdgcn_s_memrealtime() - t0 > 2000000ull) {
                    if (lane == 0) { unsigned expect = 0u; __hip_atomic_compare_exchange_strong(tmo + 1, &expect, code | (unsigned)(u.pm & 0xff), __ATOMIC_RELAXED, __ATOMIC_RELAXED, __HIP_MEMORY_SCOPE_AGENT);
                                     __hip_atomic_store(tmo, 1u, __ATOMIC_RELAXED, __HIP_MEMORY_SCOPE_AGENT); }
                    dead = true; break; }
                __builtin_amdgcn_s_sleep(2);
            }
            __builtin_amdgcn_fence(__ATOMIC_ACQUIRE, "agent");
            if (lane == 0) flag[0] = dead ? 1u : 0u;
        }
        asm volatile("s_waitcnt vmcnt(0) lgkmcnt(0)" ::: "memory"); __builtin_amdgcn_s_barrier(); asm volatile("" ::: "memory");
        const bool bad = flag[0] != 0u;
        if (lane < 32) {
            const unsigned long long* slot = (const unsigned long long*)xbuf + (size_t)(u.pm * BM + row) * 4; float mt[4], m2[4]; float ms = 0.f;
#pragma unroll
            for (int t = 0; t < 4; ++t) { if (t < ntn) { const unsigned long long w = __hip_atomic_load(slot + t, __ATOMIC_RELAXED, __HIP_MEMORY_SCOPE_AGENT); mt[t] = __uint_as_float((unsigned)w); m2[t] = __uint_as_float((unsigned)(w >> 32)); } else { mt[t] = 0.f; m2[t] = 0.f; } ms += mt[t]; }
            const float mean = ms / (float)ntn; float q = 0.f;
#pragma unroll
            for (int t = 0; t < 4; ++t) if (t < ntn) { const float dm = mt[t] - mean; q += m2[t] + 256.0f * dm * dm; }
            S[row] = (f32x2v){mean, 1.0f / sqrtf(q / (256.0f * (float)ntn) + eps)};
        }
        asm volatile("s_waitcnt lgkmcnt(0)" ::: "memory"); __builtin_amdgcn_s_barrier(); asm volatile("" ::: "memory");
        return bad;
#endif
    }
};
#if defined(PROBE_TIME) && PROBE_TIME >= 0
#define EPI_STAMP(k_) do { asm volatile("s_waitcnt vmcnt(0) lgkmcnt(0)" ::: "memory"); __builtin_amdgcn_sched_barrier(0); if (blockIdx.x == 0 && threadIdx.x == 0) { const unsigned long long t_ = __builtin_amdgcn_s_memrealtime(); \
        volatile PG8_LAS unsigned* ms_ = (volatile PG8_LAS unsigned*)(lds + 135168 + 512); ms_[2 * (k_)] = (unsigned)t_; ms_[1 + 2 * (k_)] = (unsigned)(t_ >> 32); } __builtin_amdgcn_sched_barrier(0); } while (0)
#else
#define EPI_STAMP(k_) do { } while (0)
#endif
struct EpiDeepNorm {
    static constexpr bool PERM = true, AFTER_DRAIN = true;
    const float* base; const bf16_t* base16; float* out; bf16_t* xn; int ldc; const float* gamma; const float* beta; float alpha; PanelStats st;
    __device__ __forceinline__ void fused(f32x4 (&acc)[2][2][4][2], const Unit& u, int wr, int wc, int fr, int fq, PG8_LAS unsigned char* lds, int wid, int lane) const {
        typedef float f32x2v __attribute__((ext_vector_type(2))); typedef unsigned u32x4v __attribute__((ext_vector_type(4)));
        const PG8_LAS f32x2v* S = (const PG8_LAS f32x2v*)(lds + 8192);
        const int col0 = u.pn * BM + wc * 32 + 8 * fq;
        PG8_LAS unsigned char* xslot = lds + 16384 + wid * 4096; (void)xslot;
        const int sb_ = out ? 16 : 12; (void)sb_;
        EPI_STAMP(sb_);
        if (base16) {
            u32x4v rw[2][4][2];
#if EPI_XPOSE
#pragma unroll
            for (int ai = 0; ai < 2; ++ai)
#pragma unroll
                for (int m = 0; m < 4; ++m) { const int r = ai * HALF + wr * 64 + m * 16 + (lane >> 2); const size_t off = (size_t)(u.pm * BM + r) * ldc + u.pn * BM + wc * 32 + 8 * (lane & 3);
#pragma unroll
                    for (int bj = 0; bj < 2; ++bj) rw[ai][m][bj] = *(const u32x4v*)(base16 + off + bj * HALF); }
            __builtin_amdgcn_sched_barrier(0);
            { int ns = 0;
#pragma unroll
              for (int ai = 0; ai < 2; ++ai)
#pragma unroll
                for (int m = 0; m < 4; ++m)
#pragma unroll
                    for (int bj = 0; bj < 2; ++bj) { PG8_LAS unsigned char* sl = xslot + (ns % 3) * 1280; ++ns;
                        *(PG8_LAS u32x4v*)(sl + 80 * (lane >> 2) + 16 * (lane & 3)) = rw[ai][m][bj]; rw[ai][m][bj] = *(const PG8_LAS u32x4v*)(sl + 80 * fr + 16 * fq); } }
#else
#pragma unroll
            for (int ai = 0; ai < 2; ++ai)
#pragma unroll
                for (int m = 0; m < 4; ++m) { const int r = ai * HALF + wr * 64 + m * 16 + fr; const size_t off = (size_t)(u.pm * BM + r) * ldc + col0;
#pragma unroll
                    for (int bj = 0; bj < 2; ++bj) rw[ai][m][bj] = *(const u32x4v*)(base16 + off + bj * HALF); }
#endif
#pragma unroll
            for (int ai = 0; ai < 2; ++ai)
#pragma unroll
                for (int m = 0; m < 4; ++m)
#pragma unroll
                    for (int bj = 0; bj < 2; ++bj) { const u32x4v w = rw[ai][m][bj];
                        const f32x4 b0 = (f32x4){__uint_as_float(w.x << 16), __uint_as_float(w.x & 0xffff0000u), __uint_as_float(w.y << 16), __uint_as_float(w.y & 0xffff0000u)};
                        const f32x4 b1 = (f32x4){__uint_as_float(w.z << 16), __uint_as_float(w.z & 0xffff0000u), __uint_as_float(w.w << 16), __uint_as_float(w.w & 0xffff0000u)};
                        acc[ai][bj][m][0] = acc[ai][bj][m][0] + b0 * alpha; acc[ai][bj][m][1] = acc[ai][bj][m][1] + b1 * alpha; }
        } else {
#pragma unroll
        for (int ai = 0; ai < 2; ++ai)
#pragma unroll
            for (int m = 0; m < 4; ++m) { const int r = ai * HALF + wr * 64 + m * 16 + fr; const size_t off = (size_t)(u.pm * BM + r) * ldc + col0;
#pragma unroll
                for (int bj = 0; bj < 2; ++bj)
#pragma unroll
                    for (int n = 0; n < 2; ++n) { const f32x4 bs = *(const f32x4*)(base + off + bj * HALF + 4 * n); acc[ai][bj][m][n] = acc[ai][bj][m][n] + bs * alpha; }
                asm volatile("" : "+v"(acc[ai][0][m][0]), "+v"(acc[ai][0][m][1]), "+v"(acc[ai][1][m][0]), "+v"(acc[ai][1][m][1]));
                if (m & 1) asm volatile("" ::: "memory"); }
        }
        EPI_STAMP(sb_ + 1);
        (void)st.run(acc, u, wr, wc, fr, fq, lds, wid, lane);
        EPI_STAMP(sb_ + 2);
        f32x4 gv[2][2], bv[2][2];
#pragma unroll
        for (int bj = 0; bj < 2; ++bj)
#pragma unroll
            for (int n = 0; n < 2; ++n) { gv[bj][n] = *(const f32x4*)(gamma + col0 + bj * HALF + 4 * n); bv[bj][n] = *(const f32x4*)(beta + col0 + bj * HALF + 4 * n); }
#pragma unroll
        for (int ai = 0; ai < 2; ++ai)
#pragma unroll
            for (int m = 0; m < 4; ++m) { const int r = ai * HALF + wr * 64 + m * 16 + fr; const f32x2v sr = S[r]; const size_t off = (size_t)(u.pm * BM + r) * ldc + col0;
#pragma unroll
                for (int bj = 0; bj < 2; ++bj) {
                    const f32x4 o0 = (acc[ai][bj][m][0] - sr.x) * sr.y * gv[bj][0] + bv[bj][0], o1 = (acc[ai][bj][m][1] - sr.x) * sr.y * gv[bj][1] + bv[bj][1];
#if EPI_XPOSE
                    const size_t rowb = (size_t)(u.pm * BM + ai * HALF + wr * 64 + m * 16);
                    if (out) {
                        *(PG8_LAS f32x4*)(xslot + 144 * fr + 32 * fq) = o0; *(PG8_LAS f32x4*)(xslot + 144 * fr + 32 * fq + 16) = o1;
                        const f32x4 t0 = *(const PG8_LAS f32x4*)(xslot + 144 * (lane >> 3) + 16 * (lane & 7)), t1 = *(const PG8_LAS f32x4*)(xslot + 144 * (8 + (lane >> 3)) + 16 * (lane & 7));
                        float* op = out + (rowb + (lane >> 3)) * ldc + u.pn * BM + wc * 32 + bj * HALF + 4 * (lane & 7);
#if OUT_NT
                        __builtin_nontemporal_store(t0, (f32x4*)op); __builtin_nontemporal_store(t1, (f32x4*)(op + (size_t)8 * ldc)); }
#else
                        *(f32x4*)op = t0; *(f32x4*)(op + (size_t)8 * ldc) = t1; }
#endif
                    if (xn) { u32x4v w; w.x = cvt_pk_bf16(o0[0], o0[1]); w.y = cvt_pk_bf16(o0[2], o0[3]); w.z = cvt_pk_bf16(o1[0], o1[1]); w.w = cvt_pk_bf16(o1[2], o1[3]);
                        PG8_LAS unsigned char* sl = xslot + 2304;
                        *(PG8_LAS u32x4v*)(sl + 80 * fr + 16 * fq) = w; const u32x4v wt = *(const PG8_LAS u32x4v*)(sl + 80 * (lane >> 2) + 16 * (lane & 3));
                        *(u32x4v*)(xn + (rowb + (lane >> 2)) * ldc + u.pn * BM + wc * 32 + bj * HALF + 8 * (lane & 3)) = wt; } }
#else
                    if (out) { *(f32x4*)(out + off + bj * HALF) = o0; *(f32x4*)(out + off + bj * HALF + 4) = o1; }
                    if (xn) { u32x4v w; w.x = cvt_pk_bf16(o0[0], o0[1]); w.y = cvt_pk_bf16(o0[2], o0[3]); w.z = cvt_pk_bf16(o1[0], o1[1]); w.w = cvt_pk_bf16(o1[2], o1[3]); *(u32x4v*)(xn + off + bj * HALF) = w; } }
#endif
                asm volatile("" ::: "memory"); }
        EPI_STAMP(sb_ + 3);
    }
};
__device__ __forceinline__ int pg8_tid();
template <class Epi, class Sched, bool ALIGN_EPI = false, bool SP2 = false>
__device__ __forceinline__ void gemm_phase(PG8_LAS unsigned char* lds, const Gemm g, const Sched& S, const Epi& E) {
    const int tid = pg8_tid(), wid = __builtin_amdgcn_readfirstlane(tid >> 6), lane = tid & 63, wr = wid >> 2, wc = wid & 3, fr = lane & 15, fq = lane >> 4;
    const int K = g.K, nt = K / BK;
    unsigned voffA[2], voffB[2];
#pragma unroll
    for (int i = 0; i < 2; ++i) { int R, C; stage_rc(tid * 16 + i * 8192, R, C); const int Rb = Epi::PERM ? ((R & ~31) + perm32(R & 31)) : R;
        voffA[i] = (unsigned)(R * K + C) * 2u; voffB[i] = (unsigned)(Rb * K + C) * 2u; }
    const size_t kstep = (size_t)(BK * 2);
    const size_t hstep = (size_t)HALF * K * 2;
    const size_t tstep = 2 * hstep;
    const unsigned ldsw = (unsigned)wid * 1024u;
    const int aoff = lds_byte(wr * 64 + fr, fq * 8), boff = lds_byte(wc * 32 + fr, fq * 8);
#define PG8_SA(b, h) (((b) * 2 + (h)) * HTB)
#define PG8_SB(b, h) ((4 + (b) * 2 + (h)) * HTB)
#define PG8_STAGE(bufoff, gbase, voff) do { _Pragma("unroll") for (int _i = 0; _i < 2; ++_i) \
        __builtin_amdgcn_global_load_lds((const unsigned*)((const char*)(gbase) + (voff)[_i]), (PG8_LAS unsigned*)(lds + (bufoff) + ldsw + _i * 8192), 16, 0, 0); } while (0)
#define PG8_LDA(dst, b, h) do { _Pragma("unroll") for (int m = 0; m < 4; ++m) _Pragma("unroll") for (int k = 0; k < 2; ++k) dst[m][k] = *(const PG8_LAS bf16x8*)(lds + PG8_SA(b, h) + aoff + m * 2048 + k * 1024); } while (0)
#define PG8_LDB(dst, b, h) do { _Pragma("unroll") for (int n = 0; n < 2; ++n) _Pragma("unroll") for (int k = 0; k < 2; ++k) dst[n][k] = *(const PG8_LAS bf16x8*)(lds + PG8_SB(b, h) + boff + n * 2048 + k * 1024); } while (0)
#define PG8_MMA(ai, bj, At, Bt) do { __builtin_amdgcn_s_setprio(1); _Pragma("unroll") for (int m = 0; m < 4; ++m) _Pragma("unroll") for (int n = 0; n < 2; ++n) _Pragma("unroll") for (int k = 0; k < 2; ++k) \
        acc[ai][bj][m][n] = __builtin_amdgcn_mfma_f32_16x16x32_bf16(Bt[n][k], At[m][k], acc[ai][bj][m][n], 0, 0, 0); __builtin_amdgcn_s_setprio(0); } while (0)
#define PG8_WAIT_V(n) asm volatile("s_waitcnt vmcnt(" #n ")" ::: "memory")
#define PG8_WAIT_L(n) asm volatile("s_waitcnt lgkmcnt(" #n ")" ::: "memory")
#define PG8_BAR __builtin_amdgcn_s_barrier()
#define PG8_SCHED __builtin_amdgcn_sched_barrier(0)
    Unit cur, nxt; int ui = 0;
    if (!S.next(0, cur)) return;
    f32x4 acc[2][2][4][2];
#pragma unroll
    for (int a = 0; a < 2; ++a)
#pragma unroll
        for (int b = 0; b < 2; ++b)
#pragma unroll
            for (int m = 0; m < 4; ++m)
#pragma unroll
                for (int n = 0; n < 2; ++n) acc[a][b][m][n] = (f32x4){0.f, 0.f, 0.f, 0.f};
    bf16x8 At[4][2], B0[2][2], B1[2][2];
    const char* cA = (const char*)g.A + (size_t)cur.pm * tstep; const char* cB = (const char*)g.Bt + (size_t)cur.pn * tstep;
    S.a_ready(cur);
    if constexpr (SP2) {
        PG8_STAGE(PG8_SB(0, 0), cB, voffB); PG8_STAGE(PG8_SB(0, 1), cB + hstep, voffB); PG8_STAGE(PG8_SA(0, 0), cA, voffA); PG8_STAGE(PG8_SA(0, 1), cA + hstep, voffA);
        if (wr == 1) PG8_BAR;
        PG8_WAIT_V(2); PG8_BAR;
        PG8_STAGE(PG8_SB(1, 0), cB + kstep, voffB); PG8_STAGE(PG8_SA(1, 0), cA + kstep, voffA); PG8_STAGE(PG8_SB(1, 1), cB + hstep + kstep, voffB);
        PG8_WAIT_V(6); PG8_BAR;
    } else {
        PG8_STAGE(PG8_SB(0, 0), cB, voffB); PG8_STAGE(PG8_SA(0, 0), cA, voffA); PG8_STAGE(PG8_SB(0, 1), cB + hstep, voffB); PG8_STAGE(PG8_SA(0, 1), cA + hstep, voffA);
        if (wr == 1) PG8_BAR;
        PG8_WAIT_V(4); PG8_BAR;
        PG8_STAGE(PG8_SB(1, 0), cB + kstep, voffB); PG8_STAGE(PG8_SA(1, 0), cA + kstep, voffA); PG8_STAGE(PG8_SB(1, 1), cB + hstep + kstep, voffB);
        PG8_WAIT_V(6); PG8_BAR;
    }
    for (;;) {
        const bool has_next = S.next(ui + 1, nxt);
        const char* nA = has_next ? (const char*)g.A + (size_t)nxt.pm * tstep : cA; const char* nB = has_next ? (const char*)g.Bt + (size_t)nxt.pn * tstep : cB;
        for (int t = 0; t < nt; t += 2) {
            const bool last = (t == nt - 2);
            const char* a1 = cA + (size_t)(t + 1) * kstep;
            const char* a2 = last ? nA : cA + (size_t)(t + 2) * kstep; const char* b2 = last ? nB : cB + (size_t)(t + 2) * kstep;
            const char* a3 = a2 + kstep; const char* b3 = b2 + kstep;
            if (last && has_next) S.a_ready(nxt);
            if constexpr (SP2) {
            PG8_LDB(B0, 0, 0); PG8_LDB(B1, 0, 1); PG8_SCHED; PG8_LDA(At, 0, 0); PG8_STAGE(PG8_SA(1, 1), a1 + hstep, voffA);
            PG8_WAIT_V(8); PG8_WAIT_L(0); PG8_BAR; PG8_MMA(0, 0, At, B0); PG8_MMA(0, 1, At, B1); PG8_BAR; PG8_SCHED;
            PG8_LDA(At, 0, 1); PG8_STAGE(PG8_SB(0, 0), b2, voffB); PG8_STAGE(PG8_SB(0, 1), b2 + hstep, voffB); PG8_STAGE(PG8_SA(0, 0), a2, voffA);
            PG8_WAIT_V(8); PG8_WAIT_L(0); PG8_BAR; PG8_MMA(1, 0, At, B0); PG8_MMA(1, 1, At, B1); PG8_BAR; PG8_SCHED;
            PG8_LDB(B0, 1, 0); PG8_LDB(B1, 1, 1); PG8_SCHED; PG8_LDA(At, 1, 0); PG8_STAGE(PG8_SA(0, 1), a2 + hstep, voffA);
            PG8_WAIT_V(8); PG8_WAIT_L(0); PG8_BAR; PG8_MMA(0, 0, At, B0); PG8_MMA(0, 1, At, B1); PG8_BAR; PG8_SCHED;
            PG8_LDA(At, 1, 1); PG8_STAGE(PG8_SB(1, 0), b3, voffB); PG8_STAGE(PG8_SB(1, 1), b3 + hstep, voffB); PG8_STAGE(PG8_SA(1, 0), a3, voffA);
            PG8_WAIT_V(8); PG8_WAIT_L(0); PG8_BAR; PG8_MMA(1, 0, At, B0); PG8_MMA(1, 1, At, B1); PG8_BAR; PG8_SCHED;
            } else {
            PG8_LDB(B0, 0, 0); PG8_SCHED; PG8_LDA(At, 0, 0); PG8_STAGE(PG8_SA(1, 1), a1 + hstep, voffA);
            PG8_WAIT_L(8); PG8_BAR; PG8_WAIT_L(0); PG8_MMA(0, 0, At, B0); PG8_BAR; PG8_SCHED;
            PG8_LDB(B1, 0, 1); PG8_STAGE(PG8_SB(0, 0), b2, voffB);
            PG8_BAR; PG8_WAIT_L(0); PG8_MMA(0, 1, At, B1); PG8_BAR;
            PG8_LDA(At, 0, 1); PG8_STAGE(PG8_SA(0, 0), a2, voffA);
            PG8_BAR; PG8_WAIT_L(0); PG8_MMA(1, 0, At, B0); PG8_BAR; PG8_SCHED;
            PG8_STAGE(PG8_SB(0, 1), b2 + hstep, voffB);
            PG8_WAIT_V(6); PG8_BAR; PG8_MMA(1, 1, At, B1); PG8_BAR;
            PG8_LDB(B0, 1, 0); PG8_SCHED; PG8_LDA(At, 1, 0); PG8_STAGE(PG8_SA(0, 1), a2 + hstep, voffA);
            PG8_WAIT_L(8); PG8_BAR; PG8_WAIT_L(0); PG8_MMA(0, 0, At, B0); PG8_BAR; PG8_SCHED;
            PG8_LDB(B1, 1, 1); PG8_STAGE(PG8_SB(1, 0), b3, voffB);
            PG8_BAR; PG8_WAIT_L(0); PG8_MMA(0, 1, At, B1); PG8_BAR;
            PG8_LDA(At, 1, 1); PG8_STAGE(PG8_SA(1, 0), a3, voffA);
            PG8_BAR; PG8_WAIT_L(0); PG8_MMA(1, 0, At, B0); PG8_BAR; PG8_SCHED;
            PG8_STAGE(PG8_SB(1, 1), b3 + hstep, voffB);
            PG8_WAIT_V(6); PG8_BAR; PG8_MMA(1, 1, At, B1); PG8_BAR;
            }
        }
        if constexpr (ALIGN_EPI) { if (wr == 0) PG8_BAR; }
        if constexpr (!Epi::AFTER_DRAIN) { E(acc, cur, wr, wc, fr, fq); S.done(cur); }
        if (!has_next) break;
#pragma unroll
        for (int a = 0; a < 2; ++a)
#pragma unroll
            for (int b = 0; b < 2; ++b)
#pragma unroll
                for (int m = 0; m < 4; ++m)
#pragma unroll
                    for (int n = 0; n < 2; ++n) acc[a][b][m][n] = (f32x4){0.f, 0.f, 0.f, 0.f};
        cur = nxt; cA = nA; cB = nB; ++ui;
        if constexpr (ALIGN_EPI) { if (wr == 1) PG8_BAR; }
    }
    PG8_WAIT_V(0);
    if constexpr (!ALIGN_EPI) { if (wr == 0) PG8_BAR; }
    PG8_BAR;
    if constexpr (Epi::AFTER_DRAIN) { E.fused(acc, cur, wr, wc, fr, fq, lds, wid, lane); S.done(cur); }
#undef PG8_SA
#undef PG8_SB
#undef PG8_STAGE
#undef PG8_LDA
#undef PG8_LDB
#undef PG8_MMA
#undef PG8_WAIT_V
#undef PG8_WAIT_L
#undef PG8_BAR
#undef PG8_SCHED
}
}

#ifndef PG8_SP2
#define PG8_SP2 true
#endif
#define LAS __attribute__((address_space(3)))
#define GAS __attribute__((address_space(1)))
typedef unsigned v4u __attribute__((ext_vector_type(4)));
typedef float f32x4 __attribute__((ext_vector_type(4)));
typedef short bf16x8 __attribute__((ext_vector_type(8)));
#define MFMA16(a, b, c) __builtin_amdgcn_mfma_f32_16x16x32_bf16((a), (b), (c), 0, 0, 0)
#define LDS_WAIT() asm volatile("s_waitcnt lgkmcnt(0)" ::: "memory")
#define VM_WAIT() asm volatile("s_waitcnt vmcnt(0)" ::: "memory")

constexpr int NWAVES = 8, NTHREADS = NWAVES * 64;
constexpr int RING_BYTES = 131072, MISC_OFF = 135168, LDS_BYTES = 147456;

__device__ __forceinline__ unsigned hw_wave_slot() { return (unsigned)__builtin_amdgcn_s_getreg((5 << 11) | 4) & 63u; }
__device__ __forceinline__ void park_wave_index() {
    extern __shared__ __attribute__((aligned(16))) unsigned char lds_park[];
    if ((threadIdx.x & 63) == 0) ((LAS unsigned*)((LAS unsigned char*)lds_park + MISC_OFF + 256))[hw_wave_slot()] = threadIdx.x >> 6;
}
__device__ __forceinline__ int fresh_tid() {
    extern __shared__ __attribute__((aligned(16))) unsigned char lds_park[];
    const unsigned w = __builtin_amdgcn_readfirstlane(((volatile LAS unsigned*)((LAS unsigned char*)lds_park + MISC_OFF + 256))[hw_wave_slot()]);
    unsigned l; asm volatile("v_mbcnt_lo_u32_b32 %0, -1, 0\n\tv_mbcnt_hi_u32_b32 %0, -1, %0" : "=v"(l));
    return (int)((w << 6) | l);
}
#define XB_TMO      128
#define XB_XCNT(j)  (256  + 64 * (j))
#define XB_XSUB(j)  (1280 + 64 * (j))
#define XB_XGEN(j)  (2304 + 64 * (j))
#define XB_TOP      3328
#define XB_TOPGEN   3392
#define XCD_BAR_WORDS 3456
#define XB_SPIN_CAP (1u << 18)
__device__ __forceinline__ unsigned xb_ld(unsigned* p)              { return __hip_atomic_load(p, __ATOMIC_RELAXED, __HIP_MEMORY_SCOPE_AGENT); }
__device__ __forceinline__ unsigned xb_add(unsigned* p, unsigned v) { return __hip_atomic_fetch_add(p, v, __ATOMIC_RELAXED, __HIP_MEMORY_SCOPE_AGENT); }
__device__ __forceinline__ unsigned xb_xcc_id() { return (unsigned)__builtin_amdgcn_s_getreg((3 << 11) | 20) & 0xFu; }
#define XB_SPIN(cond, bar) do { unsigned _sp = 0; while (cond) { __builtin_amdgcn_s_sleep(1); \
    if ((++_sp & 255u) == 0u) { if (xb_ld(&(bar)[XB_TMO])) break; if (_sp > XB_SPIN_CAP) { atomicAdd(&(bar)[XB_TMO], 1u); break; } } } } while (0)
struct XcdBarrier { unsigned* bar; unsigned x; volatile LAS unsigned* st; };
__device__ __forceinline__ XcdBarrier xcd_barrier_post(unsigned* bar, volatile LAS unsigned* st) {
    XcdBarrier b; b.bar = bar; b.x = xb_xcc_id(); b.st = st;
    if (threadIdx.x == 0) (void)xb_add(&bar[XB_XCNT(b.x)], 1u);
    return b;
}
__device__ __forceinline__ void xcd_barrier_complete(unsigned* bar, unsigned x, unsigned& nloc, unsigned& nx) {
    const unsigned G = gridDim.x * gridDim.y * gridDim.z;
    unsigned sum, cnt, mine, sp = 0u;
    for (;;) {
        sum = 0u; cnt = 0u; mine = 0u;
#pragma unroll
        for (unsigned j = 0; j < 16; ++j) { const unsigned c = xb_ld(&bar[XB_XCNT(j)]); sum += c; cnt += (c > 0u) ? 1u : 0u; mine = (j == x) ? c : mine; }
        if (sum == G) break;
        __builtin_amdgcn_s_sleep(1);
        if ((++sp & 255u) == 0u) { if (xb_ld(&bar[XB_TMO])) break; if (sp > XB_SPIN_CAP) { atomicAdd(&bar[XB_TMO], 1u); break; } }
    }
    nloc = mine > 0u ? mine : 1u; nx = cnt > 0u ? cnt : 1u;
}
__device__ __forceinline__ void xcd_barrier_impl(const XcdBarrier& b) {
    asm volatile("s_waitcnt vmcnt(0)" ::: "memory");
    __syncthreads();
    if (fresh_tid() == 0) {
        unsigned* bar = b.bar;
        __builtin_amdgcn_s_waitcnt(0);
        unsigned nloc = b.st[0], nx = b.st[1];
        if (nloc == 0u) { xcd_barrier_complete(bar, b.x, nloc, nx); b.st[0] = nloc; b.st[1] = nx; }
        const unsigned old = xb_add(&bar[XB_XSUB(b.x)], 1u);
        const unsigned gen = old / nloc;
#if BAR_SHORT
        if (old + 1u == (gen + 1u) * nloc) {
            __builtin_amdgcn_fence(__ATOMIC_RELEASE, "agent");
            asm volatile("s_waitcnt vmcnt(0)" ::: "memory");
            (void)xb_add(&bar[XB_TOP], 1u);
        }
#if BAR_TIGHT
        { const unsigned want = (gen + 1u) * nx; unsigned sp_ = 0u;
          while (xb_ld(&bar[XB_TOP]) < want) { if ((++sp_ & 1023u) == 0u) { if (xb_ld(&bar[XB_TMO])) break; if (sp_ > (XB_SPIN_CAP << 2)) { atomicAdd(&bar[XB_TMO], 1u); break; } } } }
#else
        { const unsigned want = (gen + 1u) * nx; XB_SPIN(xb_ld(&bar[XB_TOP]) < want, bar); }
#endif
        __builtin_amdgcn_fence(__ATOMIC_ACQUIRE, "agent");
        asm volatile("s_waitcnt vmcnt(0)" ::: "memory");
#else
        if (old + 1u == (gen + 1u) * nloc) {
            __builtin_amdgcn_fence(__ATOMIC_RELEASE, "agent");
            asm volatile("s_waitcnt vmcnt(0)" ::: "memory");
            const unsigned og = xb_add(&bar[XB_TOP], 1u);
            const unsigned tg = og / nx;
            if (og + 1u == (tg + 1u) * nx) xb_add(&bar[XB_TOPGEN], 1u);
            else XB_SPIN(xb_ld(&bar[XB_TOPGEN]) == tg, bar);
            __builtin_amdgcn_fence(__ATOMIC_ACQUIRE, "agent");
            xb_add(&bar[XB_XGEN(b.x)], 1u);
            asm volatile("s_waitcnt vmcnt(0)" ::: "memory");
        } else {
            XB_SPIN(xb_ld(&bar[XB_XGEN(b.x)]) == gen, bar);
            __builtin_amdgcn_fence(__ATOMIC_ACQUIRE, "agent");
            asm volatile("s_waitcnt vmcnt(0)" ::: "memory");
        }
#endif
    }
    __syncthreads();
}

struct Args { const float* in[21]; float* out; unsigned char* ws; int phase; int layer; };
__device__ __forceinline__ void grid_barrier(const Args& a, LAS unsigned char* lds) {
    XcdBarrier b; b.bar = (unsigned*)(a.ws + WS_CTL) + CW_BAR; b.x = xb_xcc_id(); b.st = (volatile LAS unsigned*)(lds + MISC_OFF) + 8;
    xcd_barrier_impl(b);
}
namespace pg8 { __device__ __forceinline__ int pg8_tid() { return fresh_tid(); } }
__device__ __forceinline__ int fresh_bid() { int b = blockIdx.x; asm volatile("" : "+s"(b)); return b; }

__device__ __forceinline__ void p0_transpose_item(const float* W, int K, int N, bf16_t* WT, LAS float* scr, int item, int lane) {
    const int nblk = N / 32, kb = item / nblk, nb = item % nblk, k0 = 64 * kb, n0 = 32 * nb;
    float wv[32];
#pragma unroll
#if X_NT
    for (int i = 0; i < 32; ++i) { const int kk = 2 * i + (lane >> 5); wv[i] = __builtin_nontemporal_load(W + (size_t)(k0 + kk) * N + n0 + (lane & 31)); }
#else
    for (int i = 0; i < 32; ++i) { const int kk = 2 * i + (lane >> 5); wv[i] = W[(size_t)(k0 + kk) * N + n0 + (lane & 31)]; }
#endif
#pragma unroll
    for (int i = 0; i < 32; ++i) { const int kk = 2 * i + (lane >> 5); scr[kk * 33 + (lane & 31)] = wv[i]; }
    LDS_WAIT(); asm volatile("" ::: "memory");
    const int c = lane & 7;
#pragma unroll
    for (int j = 0; j < 4; ++j) { const int n = (lane >> 3) + 8 * j; const LAS float* s = scr + (8 * c) * 33 + n;
        v4u o; o.x = pk2(s[0 * 33], s[1 * 33]); o.y = pk2(s[2 * 33], s[3 * 33]); o.z = pk2(s[4 * 33], s[5 * 33]); o.w = pk2(s[6 * 33], s[7 * 33]);
        *(v4u*)(WT + (size_t)(n0 + n) * K + k0 + 8 * c) = o; }
    LDS_WAIT(); asm volatile("" ::: "memory");
}

__device__ __forceinline__ void phase_prologue(const Args& a, LAS unsigned char* lds) {
    const int tid = fresh_tid(), bid = fresh_bid(), lane = tid & 63, wave = __builtin_amdgcn_readfirstlane(tid >> 6);
    const int gw = bid * NWAVES + wave, NGW = gridDim.x * NWAVES;
    LAS float* scr = (LAS float*)(lds + wave * 16384);
    constexpr int I_IN = (D / 64) * (DIN / 32), I_OUT = (D / 64) * (D / 32), NITEMS = 2 * (I_IN + I_OUT);
#if PRO_DEPHASE
    const bool tfirst = ((bid >> 3) & 1) == 0;
#pragma unroll 1
    for (int rep = 0; rep < 2; ++rep) {
    if ((rep == 0) == tfirst) {
#endif
    for (int it = gw; it < NITEMS; it += NGW) {
        int r = it;
        if (r < 2 * I_IN) { const int l = r / I_IN; p0_transpose_item(a.in[6] + (size_t)l * D * DIN, D, DIN, (bf16_t*)(a.ws + WS_WIN) + (size_t)l * DIN * D, scr, r % I_IN, lane); continue; }
        r -= 2 * I_IN;
        { const int l = r / I_OUT; p0_transpose_item(a.in[18] + (size_t)l * D * D, D, D, (bf16_t*)(a.ws + WS_WOUT) + (size_t)l * D * D, scr, r % I_OUT, lane); }
    }
#if PRO_DEPHASE
    } else {
#endif
#if X_COALESCED
    {
        typedef unsigned v2u_ __attribute__((ext_vector_type(2)));
        const size_t n4 = (size_t)M * D / 4, NT = (size_t)gridDim.x * NTHREADS, np4 = (size_t)MP * D / 4;
        for (size_t i0 = (size_t)bid * NTHREADS + tid; i0 < n4; i0 += 8 * NT) {
            f32x4 v[8];
#pragma unroll
            for (int u = 0; u < 8; ++u) { const size_t i = i0 + u * NT; const size_t j = i < n4 ? i : i0;
                const f32x4* src = j < np4 ? (const f32x4*)a.in[0] + j : (const f32x4*)a.in[1] + (j - np4);
                v[u] = __builtin_nontemporal_load(src); }
#pragma unroll
            for (int u = 0; u < 8; ++u) { const size_t i = i0 + u * NT; if (i < n4) { v2u_ o; o.x = pk2(v[u][0], v[u][1]); o.y = pk2(v[u][2], v[u][3]); *((v2u_*)(a.ws + WS_XN) + i) = o; } }
        }
    }
#if PRO_DEPHASE
    } }
#endif
}

#else
    const size_t n8 = (size_t)M * D / 8, NT = (size_t)gridDim.x * NTHREADS;
    for (size_t i0 = (size_t)bid * NTHREADS + tid; i0 < n8; i0 += 4 * NT) {
        f32x4 v0[4], v1[4];
#pragma unroll
        for (int u = 0; u < 4; ++u) { const size_t i = i0 + u * NT; const size_t e = (i < n8 ? i : i0) * 8;
            const float* src = e < (size_t)MP * D ? a.in[0] + e : a.in[1] + (e - (size_t)MP * D);
#if X_NT
            v0[u] = __builtin_nontemporal_load((const f32x4*)src); v1[u] = __builtin_nontemporal_load((const f32x4*)(src + 4)); }
#else
            v0[u] = *(const f32x4*)src; v1[u] = *(const f32x4*)(src + 4); }
#endif
#pragma unroll
        for (int u = 0; u < 4; ++u) { const size_t i = i0 + u * NT; if (i < n8) { const size_t e = i * 8;
            v4u o; o.x = pk2(v0[u][0], v0[u][1]); o.y = pk2(v0[u][2], v0[u][3]); o.z = pk2(v1[u][0], v1[u][1]); o.w = pk2(v1[u][2], v1[u][3]);
            *(v4u*)((bf16_t*)(a.ws + WS_XN) + e) = o; } }
    }
#if PRO_DEPHASE
    } }
#endif
}
#endif

constexpr int SG_PITCH = 2064;
static_assert(64 * SG_PITCH <= MISC_OFF, "small GEMM A tile fits below the LDS control words");
__device__ __forceinline__ void sg_stage_bf16(LAS unsigned char* lds, const bf16_t* A, int tid) {
#pragma unroll
    for (int it = 0; it < 16; ++it) { const int p = it * NTHREADS + tid, r = p >> 7, c16 = p & 127;
        *(LAS v4u*)(lds + r * SG_PITCH + c16 * 16) = *(const v4u*)(A + (size_t)r * D + c16 * 8); }
}
__device__ __forceinline__ void sg_stage_ln(LAS unsigned char* lds, const float* Y, const float* gamma, const float* beta, float* x1, int wave, int lane) {
    f32x4 gv[4], bv[4];
#pragma unroll
    for (int j = 0; j < 4; ++j) { gv[j] = *(const f32x4*)(gamma + 4 * lane + 256 * j); bv[j] = *(const f32x4*)(beta + 4 * lane + 256 * j); }
#pragma unroll 2
    for (int rr = 0; rr < 8; ++rr) {
        const int r = wave * 8 + rr;
        f32x4 v[4]; float s = 0.f;
#pragma unroll
        for (int j = 0; j < 4; ++j) { v[j] = *(const f32x4*)(Y + (size_t)r * D + 4 * lane + 256 * j); s += (v[j][0] + v[j][1]) + (v[j][2] + v[j][3]); }
        const float mean = wave_sum(s, lane) * (1.f / D); float s2 = 0.f;
#pragma unroll
        for (int j = 0; j < 4; ++j) { v[j] = v[j] - mean; s2 += (v[j][0] * v[j][0] + v[j][1] * v[j][1]) + (v[j][2] * v[j][2] + v[j][3] * v[j][3]); }
        const float rstd = rsqrtf(wave_sum(s2, lane) * (1.f / D) + LN_EPS);
#pragma unroll
        for (int j = 0; j < 4; ++j) { const f32x4 o = v[j] * rstd * gv[j] + bv[j];
            if (x1) *(f32x4*)(x1 + (size_t)r * D + 4 * lane + 256 * j) = o;
            typedef unsigned u2 __attribute__((ext_vector_type(2))); u2 w; w.x = pk2(o[0], o[1]); w.y = pk2(o[2], o[3]);
            *(LAS u2*)(lds + r * SG_PITCH + (4 * lane + 256 * j) * 2) = w; }
    }
}
struct SgB { bf16x8 f[16][2]; };
__device__ __forceinline__ void sg_loadB(SgB& B, const bf16_t* Bt, int col0, int wave, int lane) {
    const int fq = lane >> 4, lr = lane & 15, kh = wave >> 2, wc = wave & 3;
    const bf16_t* b0 = Bt + (size_t)(col0 + 32 * wc + lr) * D + 512 * kh + 8 * fq;
#pragma unroll
    for (int k = 0; k < 16; ++k) { B.f[k][0] = *(const bf16x8*)(b0 + 32 * k); B.f[k][1] = *(const bf16x8*)(b0 + (size_t)16 * D + 32 * k); }
}
__device__ __forceinline__ bool sg_mma_reduce(LAS unsigned char* lds, const SgB& B, int wave, int lane, f32x4 (&acc)[2][4]) {
    const int fq = lane >> 4, lr = lane & 15, kh = wave >> 2, wc = wave & 3;
#pragma unroll
    for (int i = 0; i < 2; ++i)
#pragma unroll
        for (int j = 0; j < 4; ++j) acc[i][j] = (f32x4){0.f, 0.f, 0.f, 0.f};
    LAS const unsigned char* a0 = lds + lr * SG_PITCH + 1024 * kh + 16 * fq;
#pragma unroll
    for (int k = 0; k < 16; ++k) {
#pragma unroll
        for (int jt = 0; jt < 4; ++jt) { const bf16x8 af = *(LAS const bf16x8*)(a0 + 16 * jt * SG_PITCH + 64 * k);
            acc[0][jt] = MFMA16(B.f[k][0], af, acc[0][jt]); acc[1][jt] = MFMA16(B.f[k][1], af, acc[1][jt]); }
    }
    __syncthreads();
    LAS f32x4* xb = (LAS f32x4*)lds + (size_t)wc * 512 + lane;
    if (kh == 1) {
#pragma unroll
        for (int i = 0; i < 2; ++i)
#pragma unroll
            for (int j = 0; j < 4; ++j) xb[(i * 4 + j) * 64] = acc[i][j];
    }
    __syncthreads();
    if (kh == 0) {
#pragma unroll
        for (int i = 0; i < 2; ++i)
#pragma unroll
            for (int j = 0; j < 4; ++j) acc[i][j] = acc[i][j] + xb[(i * 4 + j) * 64];
    }
    return kh == 0;
}
__device__ __forceinline__ void sample_in_tile(const Args& a, LAS unsigned char* lds, int layer, int it) {
    const int tid = fresh_tid(), lane = tid & 63, wave = __builtin_amdgcn_readfirstlane(tid >> 6);
    const int rt = it / 24, ct = it % 24;
    SgB B; sg_loadB(B, (const bf16_t*)(a.ws + WS_WIN) + (size_t)layer * DIN * D, ct * 128, wave, lane);
    sg_stage_bf16(lds, (const bf16_t*)(a.ws + WS_XN) + (size_t)(MP + 64 * rt) * D, tid);
    __syncthreads();
    f32x4 acc[2][4];
    if (sg_mma_reduce(lds, B, wave, lane, acc)) {
        const int fq = lane >> 4, lr = lane & 15, wc = wave & 3;
        bf16_t* proj = (bf16_t*)(a.ws + WS_PROJ) + (size_t)(MP + 64 * rt + lr) * DIN + ct * 128 + 32 * wc + 4 * fq;
#pragma unroll
        for (int jn = 0; jn < 2; ++jn)
#pragma unroll
            for (int jt = 0; jt < 4; ++jt) { typedef unsigned u2 __attribute__((ext_vector_type(2))); u2 w; w.x = pk2(acc[jn][jt][0], acc[jn][jt][1]); w.y = pk2(acc[jn][jt][2], acc[jn][jt][3]);
                *(u2*)(proj + (size_t)(16 * jt) * DIN + 16 * jn) = w; }
    }
    __syncthreads();
}
__device__ __forceinline__ void sample_out_tile(const Args& a, LAS unsigned char* lds, int layer, int it) {
    const int tid = fresh_tid(), lane = tid & 63, wave = __builtin_amdgcn_readfirstlane(tid >> 6);
    const int rt = it >> 3, ct = it & 7;
    SgB B; sg_loadB(B, (const bf16_t*)(a.ws + WS_WOUT) + (size_t)layer * D * D, ct * 128, wave, lane);
    sg_stage_bf16(lds, (const bf16_t*)(a.ws + WS_YMIX) + (size_t)(MP + 64 * rt) * D, tid);
    __syncthreads();
    f32x4 acc[2][4];
    if (sg_mma_reduce(lds, B, wave, lane, acc)) {
        const int fq = lane >> 4, lr = lane & 15, wc = wave & 3;
        const size_t off = (size_t)(64 * rt + lr) * D + ct * 128 + 32 * wc + 4 * fq;
        const float* res = (layer == 0 ? a.in[1] : (const float*)(a.ws + WS_X1S)) + off;
        float* yp = (float*)(a.ws + WS_YPRE) + off;
#pragma unroll
        for (int jn = 0; jn < 2; ++jn)
#pragma unroll
            for (int jt = 0; jt < 4; ++jt) { const f32x4 x = *(const f32x4*)(res + (size_t)(16 * jt) * D + 16 * jn);
                *(f32x4*)(yp + (size_t)(16 * jt) * D + 16 * jn) = x * DN_ALPHA + acc[jn][jt]; }
    }
    {
        asm volatile("s_waitcnt vmcnt(0)" ::: "memory");
        __syncthreads();
        if (tid == 0) { __builtin_amdgcn_fence(__ATOMIC_RELEASE, "agent"); asm volatile("s_waitcnt vmcnt(0)" ::: "memory");
            __hip_atomic_fetch_add((unsigned*)(a.ws + WS_CTL) + CW_SAMP + 64 * (8 * layer + rt), 1u, __ATOMIC_RELAXED, __HIP_MEMORY_SCOPE_AGENT); }
    }
    __syncthreads();
}
__device__ __forceinline__ void sample_final_ln_rows(const Args& a, int layer, int it) {
    const int tid = fresh_tid(), lane = tid & 63, wave = __builtin_amdgcn_readfirstlane(tid >> 6);
#if SAMPLE_OUT_KSLICE
    const int rt = it >> 5; const unsigned want = 32u;
#else
    const int rt = it >> 3, ct = it & 7; const unsigned want = 8u;
#endif
    if (wave == 0) {
        unsigned* cnt = (unsigned*)(a.ws + WS_CTL) + CW_SAMP + 64 * (8 * layer + rt); unsigned sp = 0;
        while ((unsigned)__builtin_amdgcn_readfirstlane(__hip_atomic_load(cnt, __ATOMIC_RELAXED, __HIP_MEMORY_SCOPE_AGENT)) < want) { __builtin_amdgcn_s_sleep(2); if (++sp > (1u << 20)) break; }
        __builtin_amdgcn_fence(__ATOMIC_ACQUIRE, "agent");
        asm volatile("s_waitcnt vmcnt(0)" ::: "memory");
    }
    __syncthreads();
#if SAMPLE_OUT_KSLICE
    if (wave >= 2) return;
    const int r = 64 * rt + 2 * (it & 31) + wave;
#else
    const int r = 64 * rt + 8 * ct + wave;
#endif
    const float* gamma = a.in[19] + layer * D; const float* beta = a.in[20] + layer * D;
    const float* Y = (const float*)(a.ws + WS_YPRE) + (size_t)r * D;
    float* o = layer == DEPTH - 1 ? a.out + O_YS + (size_t)r * D : (float*)(a.ws + WS_X1S) + (size_t)r * D;
    bf16_t* xn = layer == DEPTH - 1 ? nullptr : (bf16_t*)(a.ws + WS_XN) + (size_t)(MP + r) * D;
#if LN_TAIL_FAST
    f32x4 v[4], gmv[4], btv[4]; float s = 0.f, s2 = 0.f;
#pragma unroll
    for (int j = 0; j < 4; ++j) { v[j] = *(const f32x4*)(Y + 4 * lane + 256 * j); gmv[j] = *(const f32x4*)(gamma + 4 * lane + 256 * j); btv[j] = *(const f32x4*)(beta + 4 * lane + 256 * j); }
    const float piv = __builtin_bit_cast(float, __builtin_amdgcn_readfirstlane(__builtin_bit_cast(int, v[0][0])));
#pragma unroll
    for (int j = 0; j < 4; ++j) { v[j] = v[j] - piv; s += (v[j][0] + v[j][1]) + (v[j][2] + v[j][3]); s2 += (v[j][0] * v[j][0] + v[j][1] * v[j][1]) + (v[j][2] * v[j][2] + v[j][3] * v[j][3]); }
#pragma unroll
    for (int o_ = 1; o_ < 64; o_ <<= 1) { const float t1 = shx(s, o_, lane), t2 = shx(s2, o_, lane); s += t1; s2 += t2; }
    const float mean = s * (1.f / D);
    const float rstd = rsqrtf(fmaxf(s2 * (1.f / D) - mean * mean, 0.f) + LN_EPS);
#pragma unroll
    for (int j = 0; j < 4; ++j) { const f32x4 y = (v[j] - mean) * rstd * gmv[j] + btv[j];
        *(f32x4*)(o + 4 * lane + 256 * j) = y;
#else
    f32x4 v[4]; float s = 0.f;
#pragma unroll
    for (int j = 0; j < 4; ++j) { v[j] = *(const f32x4*)(Y + 4 * lane + 256 * j); s += (v[j][0] + v[j][1]) + (v[j][2] + v[j][3]); }
    const float mean = wave_sum(s, lane) * (1.f / D); float s2 = 0.f;
#pragma unroll
    for (int j = 0; j < 4; ++j) { v[j] = v[j] - mean; s2 += (v[j][0] * v[j][0] + v[j][1] * v[j][1]) + (v[j][2] * v[j][2] + v[j][3] * v[j][3]); }
    const float rstd = rsqrtf(wave_sum(s2, lane) * (1.f / D) + LN_EPS);
#pragma unroll
    for (int j = 0; j < 4; ++j) { const f32x4 y = v[j] * rstd * *(const f32x4*)(gamma + 4 * lane + 256 * j) + *(const f32x4*)(beta + 4 * lane + 256 * j);
        *(f32x4*)(o + 4 * lane + 256 * j) = y;
#endif

        if (xn) { typedef unsigned u2_ __attribute__((ext_vector_type(2))); u2_ w; w.x = pk2(y[0], y[1]); w.y = pk2(y[2], y[3]); *(u2_*)(xn + 4 * lane + 256 * j) = w; } }
}
__device__ __forceinline__ void phase_sample_final_ln(const Args& a) {
    const int tid = fresh_tid(), lane = tid & 63, wave = __builtin_amdgcn_readfirstlane(tid >> 6);
    const int gw = fresh_bid() * NWAVES + wave, NGW = gridDim.x * NWAVES;
    const float* gamma = a.in[19] + (DEPTH - 1) * D; const float* beta = a.in[20] + (DEPTH - 1) * D;
    for (int r = gw; r < MS; r += NGW) {
        const float* Y = (const float*)(a.ws + WS_YPRE) + (size_t)r * D; float* o = a.out + O_YS + (size_t)r * D;
        f32x4 v[4]; float s = 0.f;
#pragma unroll
        for (int j = 0; j < 4; ++j) { v[j] = *(const f32x4*)(Y + 4 * lane + 256 * j); s += (v[j][0] + v[j][1]) + (v[j][2] + v[j][3]); }
        const float mean = wave_sum(s, lane) * (1.f / D); float s2 = 0.f;
#pragma unroll
        for (int j = 0; j < 4; ++j) { v[j] = v[j] - mean; s2 += (v[j][0] * v[j][0] + v[j][1] * v[j][1]) + (v[j][2] * v[j][2] + v[j][3] * v[j][3]); }
        const float rstd = rsqrtf(wave_sum(s2, lane) * (1.f / D) + LN_EPS);
#pragma unroll
        for (int j = 0; j < 4; ++j) *(f32x4*)(o + 4 * lane + 256 * j) = v[j] * rstd * *(const f32x4*)(gamma + 4 * lane + 256 * j) + *(const f32x4*)(beta + 4 * lane + 256 * j);
    }
}

__device__ __forceinline__ bf16x8 sg_xpose(LAS unsigned char* slot, bf16x8 raw, int lane) {
    *(LAS bf16x8*)(slot + 80 * (lane >> 2) + 16 * (lane & 3)) = raw;
    return *(LAS const bf16x8*)(slot + 80 * (lane & 15) + 16 * (lane >> 4));
}
__device__ __forceinline__ void sg_xpose2(LAS unsigned char* slot, bf16x8 r0, bf16x8 r1, int lane, bf16x8& f0, bf16x8& f1) {
    *(LAS bf16x8*)(slot + 144 * (lane >> 3) + 16 * (lane & 7)) = r0;
    *(LAS bf16x8*)(slot + 144 * (8 + (lane >> 3)) + 16 * (lane & 7)) = r1;
    f0 = *(LAS const bf16x8*)(slot + 144 * (lane & 15) + 16 * (lane >> 4));
    f1 = *(LAS const bf16x8*)(slot + 144 * (lane & 15) + 64 + 16 * (lane >> 4));
}
__device__ __forceinline__ void sample_out_unit(const Args& a, LAS unsigned char* lds, int layer, int it) {
    const int tid = fresh_tid(), lane = tid & 63, wave = __builtin_amdgcn_readfirstlane(tid >> 6);
    const int rt = it >> 5, col0 = (it & 31) * 32;
    const int fq = lane >> 4, lr = lane & 15;
#if SG_XPOSE == 2
    const bf16_t* Ap = (const bf16_t*)(a.ws + WS_YMIX) + (size_t)(MP + 64 * rt + (lane >> 3)) * D + 128 * wave + 8 * (lane & 7);
    const bf16_t* Bp = (const bf16_t*)(a.ws + WS_WOUT) + (size_t)layer * D * D + (size_t)(col0 + (lane >> 3)) * D + 128 * wave + 8 * (lane & 7);
#elif SG_XPOSE
    const bf16_t* Ap = (const bf16_t*)(a.ws + WS_YMIX) + (size_t)(MP + 64 * rt + (lane >> 2)) * D + 128 * wave + 8 * (lane & 3);
    const bf16_t* Bp = (const bf16_t*)(a.ws + WS_WOUT) + (size_t)layer * D * D + (size_t)(col0 + (lane >> 2)) * D + 128 * wave + 8 * (lane & 3);
#else
    const bf16_t* Ap = (const bf16_t*)(a.ws + WS_YMIX) + (size_t)(MP + 64 * rt + lr) * D + 128 * wave + 8 * fq;
    const bf16_t* Bp = (const bf16_t*)(a.ws + WS_WOUT) + (size_t)layer * D * D + (size_t)(col0 + lr) * D + 128 * wave + 8 * fq;
#endif
    bf16x8 Af[4][4], Bf[2][4];
#pragma unroll
    for (int jn = 0; jn < 2; ++jn)
#pragma unroll
#if SG_XPOSE == 2
        for (int kk = 0; kk < 4; ++kk) Bf[jn][kk] = *(const bf16x8*)(Bp + (size_t)(16 * jn + 8 * (kk & 1)) * D + 64 * (kk >> 1));
#else
        for (int kk = 0; kk < 4; ++kk) Bf[jn][kk] = *(const bf16x8*)(Bp + (size_t)(16 * jn) * D + 32 * kk);
#endif
#pragma unroll
    for (int jt = 0; jt < 4; ++jt)
#pragma unroll
#if SG_XPOSE == 2
        for (int kk = 0; kk < 4; ++kk) Af[jt][kk] = *(const bf16x8*)(Ap + (size_t)(16 * jt + 8 * (kk & 1)) * D + 64 * (kk >> 1));
#else
        for (int kk = 0; kk < 4; ++kk) Af[jt][kk] = *(const bf16x8*)(Ap + (size_t)(16 * jt) * D + 32 * kk);
#endif
    const int jn_o = wave >> 2, jt_o = wave & 3;
    const size_t off = (size_t)(64 * rt + 16 * jt_o + lr) * D + col0 + 16 * jn_o + 4 * fq;
    const f32x4 x = *(const f32x4*)((layer == 0 ? a.in[1] : (const float*)(a.ws + WS_X1S)) + off);
    __builtin_amdgcn_sched_barrier(0);
#if SG_XPOSE == 2
    { LAS unsigned char* scr = lds + 65536 + wave * 4096;
#pragma unroll
      for (int kp = 0; kp < 2; ++kp) {
#pragma unroll
        for (int jn = 0; jn < 2; ++jn) sg_xpose2(scr, Bf[jn][2 * kp], Bf[jn][2 * kp + 1], lane, Bf[jn][2 * kp], Bf[jn][2 * kp + 1]);
#pragma unroll
        for (int jt = 0; jt < 4; ++jt) sg_xpose2(scr, Af[jt][2 * kp], Af[jt][2 * kp + 1], lane, Af[jt][2 * kp], Af[jt][2 * kp + 1]);
      } }
#elif SG_XPOSE
    { LAS unsigned char* scr = lds + 65536 + wave * 4096; int ns = 0;
#pragma unroll
      for (int kk = 0; kk < 4; ++kk) {
#pragma unroll
        for (int jn = 0; jn < 2; ++jn) { Bf[jn][kk] = sg_xpose(scr + (ns % 3) * 1280, Bf[jn][kk], lane); ++ns; }
#pragma unroll
        for (int jt = 0; jt < 4; ++jt) { Af[jt][kk] = sg_xpose(scr + (ns % 3) * 1280, Af[jt][kk], lane); ++ns; }
      } }
#endif
    f32x4 acc[2][4];
#pragma unroll
    for (int i = 0; i < 2; ++i)
#pragma unroll
        for (int j = 0; j < 4; ++j) acc[i][j] = (f32x4){0.f, 0.f, 0.f, 0.f};
#pragma unroll
    for (int kk = 0; kk < 4; ++kk)
#pragma unroll
        for (int jt = 0; jt < 4; ++jt) { acc[0][jt] = MFMA16(Bf[0][kk], Af[jt][kk], acc[0][jt]); acc[1][jt] = MFMA16(Bf[1][kk], Af[jt][kk], acc[1][jt]); }
    LAS f32x4* xb = (LAS f32x4*)lds;
#pragma unroll
    for (int i = 0; i < 2; ++i)
#pragma unroll
        for (int j = 0; j < 4; ++j) xb[wave * 512 + (i * 4 + j) * 64 + lane] = acc[i][j];
    __syncthreads();
    f32x4 sum = xb[tid];
#pragma unroll
    for (int w = 1; w < 8; ++w) sum = sum + xb[w * 512 + tid];
    *(f32x4*)((float*)(a.ws + WS_YPRE) + off) = x * DN_ALPHA + sum;
    __syncthreads();
}
__device__ __forceinline__ void sample_in_unit(const Args& a, LAS unsigned char* lds, int layer, int it) {
    const int tid = fresh_tid(), lane = tid & 63, wave = __builtin_amdgcn_readfirstlane(tid >> 6);
    const int rt = it >> 5, col0 = (it & 31) * 96;
    const int fq = lane >> 4, lr = lane & 15;
#if SG_XPOSE == 2
    const bf16_t* Ap = (const bf16_t*)(a.ws + WS_XN) + (size_t)(MP + 64 * rt + (lane >> 3)) * D + 128 * wave + 8 * (lane & 7);
    const bf16_t* Bp = (const bf16_t*)(a.ws + WS_WIN) + (size_t)layer * DIN * D + (size_t)(col0 + (lane >> 3)) * D + 128 * wave + 8 * (lane & 7);
#elif SG_XPOSE
    const bf16_t* Ap = (const bf16_t*)(a.ws + WS_XN) + (size_t)(MP + 64 * rt + (lane >> 2)) * D + 128 * wave + 8 * (lane & 3);
    const bf16_t* Bp = (const bf16_t*)(a.ws + WS_WIN) + (size_t)layer * DIN * D + (size_t)(col0 + (lane >> 2)) * D + 128 * wave + 8 * (lane & 3);
#else
    const bf16_t* Ap = (const bf16_t*)(a.ws + WS_XN) + (size_t)(MP + 64 * rt + lr) * D + 128 * wave + 8 * fq;
    const bf16_t* Bp = (const bf16_t*)(a.ws + WS_WIN) + (size_t)layer * DIN * D + (size_t)(col0 + lr) * D + 128 * wave + 8 * fq;
#endif
    (void)fq; (void)lr;
    bf16x8 Af[4][4], Bf[6][4];
#pragma unroll
    for (int jt = 0; jt < 4; ++jt)
#pragma unroll
#if SG_XPOSE == 2
        for (int kk = 0; kk < 4; ++kk) Af[jt][kk] = *(const bf16x8*)(Ap + (size_t)(16 * jt + 8 * (kk & 1)) * D + 64 * (kk >> 1));
#else
        for (int kk = 0; kk < 4; ++kk) Af[jt][kk] = *(const bf16x8*)(Ap + (size_t)(16 * jt) * D + 32 * kk);
#endif
#pragma unroll
    for (int jn = 0; jn < 6; ++jn)
#pragma unroll
#if SG_XPOSE == 2
        for (int kk = 0; kk < 4; ++kk) Bf[jn][kk] = *(const bf16x8*)(Bp + (size_t)(16 * jn + 8 * (kk & 1)) * D + 64 * (kk >> 1));
#else
        for (int kk = 0; kk < 4; ++kk) Bf[jn][kk] = *(const bf16x8*)(Bp + (size_t)(16 * jn) * D + 32 * kk);
#endif
    __builtin_amdgcn_sched_barrier(0);
#if SG_XPOSE == 2
    { LAS unsigned char* scr = lds + 98304 + wave * 4096;
#pragma unroll
      for (int jt = 0; jt < 4; ++jt)
#pragma unroll
        for (int kp = 0; kp < 2; ++kp) sg_xpose2(scr, Af[jt][2 * kp], Af[jt][2 * kp + 1], lane, Af[jt][2 * kp], Af[jt][2 * kp + 1]);
#pragma unroll
      for (int jn = 0; jn < 6; ++jn)
#pragma unroll
        for (int kp = 0; kp < 2; ++kp) sg_xpose2(scr, Bf[jn][2 * kp], Bf[jn][2 * kp + 1], lane, Bf[jn][2 * kp], Bf[jn][2 * kp + 1]); }
#elif SG_XPOSE
    { LAS unsigned char* scr = lds + 98304 + wave * 4096; int ns = 0;
#pragma unroll
      for (int jt = 0; jt < 4; ++jt)
#pragma unroll
        for (int kk = 0; kk < 4; ++kk) { Af[jt][kk] = sg_xpose(scr + (ns % 3) * 1280, Af[jt][kk], lane); ++ns; }
#pragma unroll
      for (int jn = 0; jn < 6; ++jn)
#pragma unroll
        for (int kk = 0; kk < 4; ++kk) { Bf[jn][kk] = sg_xpose(scr + (ns % 3) * 1280, Bf[jn][kk], lane); ++ns; } }
#endif
    LAS f32x4* xb = (LAS f32x4*)lds;
    bf16_t* proj = (bf16_t*)(a.ws + WS_PROJ) + (size_t)(MP + 64 * rt) * DIN + col0;
#pragma unroll
    for (int h = 0; h < 2; ++h) {
        f32x4 acc[3][4];
#pragma unroll
        for (int i = 0; i < 3; ++i)
#pragma unroll
            for (int j = 0; j < 4; ++j) acc[i][j] = (f32x4){0.f, 0.f, 0.f, 0.f};
#pragma unroll
        for (int kk = 0; kk < 4; ++kk)
#pragma unroll
            for (int jt = 0; jt < 4; ++jt)
#pragma unroll
                for (int i = 0; i < 3; ++i) acc[i][jt] = MFMA16(Bf[3 * h + i][kk], Af[jt][kk], acc[i][jt]);
        if (h) __syncthreads();
#pragma unroll
        for (int i = 0; i < 3; ++i)
#pragma unroll
            for (int j = 0; j < 4; ++j) xb[wave * 768 + (i * 4 + j) * 64 + lane] = acc[i][j];
        __syncthreads();
#pragma unroll
        for (int pp = 0; pp < 2; ++pp) {
            const int p = tid + 512 * pp;
            if (p < 768) {
                f32x4 sum = xb[p];
#pragma unroll
                for (int w = 1; w < 8; ++w) sum = sum + xb[w * 768 + p];
                const int pj = p >> 6, pl = p & 63, i = pj >> 2, jt = pj & 3;
                typedef unsigned u2 __attribute__((ext_vector_type(2))); u2 wv; wv.x = pk2(sum[0], sum[1]); wv.y = pk2(sum[2], sum[3]);
                *(u2*)(proj + (size_t)(16 * jt + (pl & 15)) * DIN + 48 * h + 16 * i + 4 * (pl >> 4)) = wv;
            }
        }
    }
    __syncthreads();
}
#if defined(PROBE_TIME) && PROBE_TIME >= 0
#define FSTAMP(k_) do { asm volatile("s_waitcnt vmcnt(0) lgkmcnt(0)" ::: "memory"); if (fresh_bid() == 0 && fresh_tid() == 0) { const unsigned long long t_ = __builtin_amdgcn_s_memrealtime(); \
        volatile LAS unsigned* ms_ = (volatile LAS unsigned*)(lds + MISC_OFF + 512); ms_[2 * (k_)] = (unsigned)t_; ms_[1 + 2 * (k_)] = (unsigned)(t_ >> 32); } } while (0)
#else
#define FSTAMP(k_) do { } while (0)
#endif
__device__ __forceinline__ void phase_gemm_in(const Args& a, LAS unsigned char* lds, int layer) {
    FSTAMP(24 + 2 * layer);
#if SAMPLE_IN_KSLICE
#if GIN_DEPHASE
    if (((fresh_bid() >> GIN_DEPHASE_SHIFT) & 1) == 0)
#endif
    sample_in_unit(a, lds, layer, fresh_bid());
#else
    { const int bid = fresh_bid(); if (bid < 192) sample_in_tile(a, lds, layer, bid); }
#endif
    FSTAMP(25 + 2 * layer);
    pg8::Gemm g{(const bf16_t*)(a.ws + WS_XN), (const bf16_t*)(a.ws + WS_WIN) + (size_t)layer * DIN * D, MP, DIN, D};
    pg8::StaticOrder S; S.init(MP, DIN, (int)gridDim.x, fresh_bid());
    pg8::EpiBf16<0> E{(bf16_t*)(a.ws + WS_PROJ), DIN, nullptr, 0, 0, 1.f};
    pg8::gemm_phase<pg8::EpiBf16<0>, pg8::StaticOrder, GIN_ALIGN, GIN_SP2>(lds, g, S, E);
#if SAMPLE_IN_KSLICE && GIN_DEPHASE
    if (((fresh_bid() >> GIN_DEPHASE_SHIFT) & 1) != 0) { __syncthreads(); sample_in_unit(a, lds, layer, fresh_bid()); }
#endif
}

__device__ __forceinline__ void phase_gemm_out(const Args& a, LAS unsigned char* lds, int layer) {
    unsigned* ctl = (unsigned*)(a.ws + WS_CTL);
#if SAMPLE_OUT_KSLICE
    FSTAMP(22); sample_out_unit(a, lds, layer, fresh_bid()); FSTAMP(23);
#else
    { const int bid = fresh_bid(); if (bid >= 192) sample_out_tile(a, lds, layer, bid - 192); }
#endif
    float* outp = layer == DEPTH - 1 ? a.out : nullptr;
    bf16_t* xn = layer == DEPTH - 1 ? nullptr : (bf16_t*)(a.ws + WS_XN);
    const float* base = nullptr;
    const bf16_t* base16 = (const bf16_t*)(a.ws + WS_XN);
    pg8::Gemm g{(const bf16_t*)(a.ws + WS_YMIX), (const bf16_t*)(a.ws + WS_WOUT) + (size_t)layer * D * D, MP, D, D};
    pg8::StaticOrder S; S.init(MP, D, (int)gridDim.x, fresh_bid());
#if RES_PREFETCH
    {
        pg8::Unit u0;
        if (S.next(0, u0)) {
            const int tid = fresh_tid(); const int wv = __builtin_amdgcn_readfirstlane(tid >> 6);
            const char* p = (const char*)base16 + ((size_t)(u0.pm * 256 + (tid >> 1)) * D + (size_t)u0.pn * 256) * 2 + (tid & 1) * 256;
            LAS unsigned* dump = (LAS unsigned*)(lds + MISC_OFF + 2048 + wv * 256);
            __builtin_amdgcn_global_load_lds((const unsigned*)p, dump, 4, 0, 0);
            __builtin_amdgcn_global_load_lds((const unsigned*)(p + 128), dump, 4, 0, 0);
        }
    }
#endif
    pg8::PanelStats st{(unsigned*)(a.ws + WS_XBUF + (size_t)layer * XBUF_LAYER), ctl + CW_SEAM + layer * SEAM_BANK, ctl + CW_TMO, 4, LN_EPS, 0x700u + (unsigned)layer * 0x40u};
#if SAMPLE_OUT_KSLICE
    st.pub = ctl + CW_SAMP + 64 * (8 * layer + (fresh_bid() >> 5));
#endif
    pg8::EpiDeepNorm E{base, base16, outp, xn, D, a.in[19] + layer * D, a.in[20] + layer * D, DN_ALPHA, st};
    pg8::gemm_phase<pg8::EpiDeepNorm, pg8::StaticOrder, false, true>(lds, g, S, E);
#if FINAL_LN_INLINE
#if SAMPLE_OUT_KSLICE
    { __syncthreads(); sample_final_ln_rows(a, layer, fresh_bid()); }
#else
    { const int bid = fresh_bid(); if (bid >= 192) { __syncthreads(); sample_final_ln_rows(a, layer, bid - 192); } }
#endif
#endif
}

typedef short s16x4 __attribute__((ext_vector_type(4)));
typedef float f32x2 __attribute__((ext_vector_type(2)));
typedef unsigned v2u __attribute__((ext_vector_type(2)));
#define DI __device__ __forceinline__
constexpr int NCHUNK = 272;
constexpr size_t WS_U = WS_YMIX;
constexpr size_t WS_ROPE = WS_MISC;
constexpr size_t WS_GATEW = WS_MISC + 1 * MiB;
constexpr size_t WS_RGA = WS_GATEW + 256 * 1024, WS_RGB = WS_RGA + 576 * 1024, WS_HST = WS_RGB + 576 * 1024, WS_CL = WS_HST + 576 * 1024;
constexpr size_t WS_LS = WS_CL + 272 * 1024;
constexpr size_t WS_LBT = WS_LS + 4096;
static_assert(WS_CL + (size_t)NCHUNK * 256 * 4 <= WS_LS && WS_LBT + 2048 <= WS_END && (size_t)NCHUNK * 8 * 4096 * 4 <= 34 * MiB && WS_ST + (size_t)NCHUNK * 8 * 4096 * 2 <= WS_P, "mixer scratch map");

DI void chunk_info(int ch, int& row0, int& pos0, int& q, int& c) {
    if (ch < 256) { q = ch >> 6; c = ch & 63; row0 = ch * 64; pos0 = c * 64; }
    else { q = NB + (ch - 256); c = 0; row0 = MP + (ch - 256) * DS; pos0 = PAST; }
}
DI bf16x8 pack8(const float (&v)[8]) { v4u o; o.x = pk2(v[0], v[1]); o.y = pk2(v[2], v[3]); o.z = pk2(v[4], v[5]); o.w = pk2(v[6], v[7]); return __builtin_bit_cast(bf16x8, o); }
DI void unpack8(const v4u w, float (&v)[8]) {
    v[0] = __uint_as_float(w.x << 16); v[1] = __uint_as_float(w.x & 0xffff0000u); v[2] = __uint_as_float(w.y << 16); v[3] = __uint_as_float(w.y & 0xffff0000u);
    v[4] = __uint_as_float(w.z << 16); v[5] = __uint_as_float(w.z & 0xffff0000u); v[6] = __uint_as_float(w.w << 16); v[7] = __uint_as_float(w.w & 0xffff0000u);
}
DI void load8f(const float* p, float (&v)[8]) { const f32x4 a = *(const f32x4*)p, b = *(const f32x4*)(p + 4); v[0] = a[0]; v[1] = a[1]; v[2] = a[2]; v[3] = a[3]; v[4] = b[0]; v[5] = b[1]; v[6] = b[2]; v[7] = b[3]; }
#define FRAG_ROW(lane_) ((lane_) >> 2)
#define FRAG_CHK(lane_) ((lane_) & 3)
DI v4u frag_perm(v4u x, int lane) {
    const int src = (4 * (lane & 15) + (lane >> 4)) << 2; v4u r;
    r.x = (unsigned)__builtin_amdgcn_ds_bpermute(src, (int)x.x); r.y = (unsigned)__builtin_amdgcn_ds_bpermute(src, (int)x.y);
    r.z = (unsigned)__builtin_amdgcn_ds_bpermute(src, (int)x.z); r.w = (unsigned)__builtin_amdgcn_ds_bpermute(src, (int)x.w);
    return r;
}
DI bf16x8 frag_perm8(bf16x8 x, int lane) { return __builtin_bit_cast(bf16x8, frag_perm(__builtin_bit_cast(v4u, x), lane)); }
DI void load8f_lds(LAS const float* p, float (&v)[8]) { const f32x4 a = *(LAS const f32x4*)p, b = *(LAS const f32x4*)(p + 4); v[0] = a[0]; v[1] = a[1]; v[2] = a[2]; v[3] = a[3]; v[4] = b[0]; v[5] = b[1]; v[6] = b[2]; v[7] = b[3]; }
DI bf16x8 tr_frag(LAS const bf16_t* tile, int k0, int i0, int lane) {
    const int fq = lane >> 4, ii = lane & 15;
    LAS const bf16_t* p = tile + (k0 + 4 * fq + (ii >> 2)) * 64 + i0 + 4 * (ii & 3);
    const s16x4 lo = __builtin_amdgcn_ds_read_tr16_b64_v4i16((LAS s16x4*)p);
    const s16x4 hi = __builtin_amdgcn_ds_read_tr16_b64_v4i16((LAS s16x4*)(p + 16 * 64));
    return __builtin_shufflevector(lo, hi, 0, 1, 2, 3, 4, 5, 6, 7);
}
template <int L> DI void stage_tile(LAS bf16_t* dst, const bf16_t* src, int lane) {
#pragma unroll
    for (int p = 0; p < L / 8; ++p) { const int r = p * 8 + (lane >> 3), cc = (lane & 7) * 8; *(LAS v4u*)(dst + r * 64 + cc) = *(const v4u*)(src + (size_t)r * DIN + cc); }
}
DI float ret_log2g(int h) { return log1pf(-exp2f(-5.f - (float)h)) * 1.4426950408889634f; }

template <int L> DI void ut_product(LAS const bf16_t* vv, LAS const bf16_t* kd, bf16_t* ut, int lane) {
    f32x4 acc[4][4];
#pragma unroll
    for (int i = 0; i < 4; ++i)
#pragma unroll
        for (int j = 0; j < 4; ++j) acc[i][j] = (f32x4){0.f, 0.f, 0.f, 0.f};
#pragma unroll
    for (int ks = 0; ks < L / 32; ++ks) {
        bf16x8 xv[4], yk[4];
#pragma unroll
        for (int n = 0; n < 4; ++n) { xv[n] = tr_frag(vv, 32 * ks, 16 * n, lane); yk[n] = tr_frag(kd, 32 * ks, 16 * n, lane); }
#pragma unroll
        for (int nd = 0; nd < 4; ++nd)
#pragma unroll
            for (int ne = 0; ne < 4; ++ne) acc[nd][ne] = MFMA16(yk[nd], xv[ne], acc[nd][ne]);
    }
    const int fq = lane >> 4, lr = lane & 15;
#if UT_XPOSE
    LAS unsigned char* xs = (LAS unsigned char*)vv;
#pragma unroll
    for (int ne = 0; ne < 4; ++ne) {
        LAS unsigned char* sl = xs + (ne & 1) * 2304;
#pragma unroll
        for (int nd = 0; nd < 4; ++nd) { v2u w; w.x = pk2(acc[nd][ne][0], acc[nd][ne][1]); w.y = pk2(acc[nd][ne][2], acc[nd][ne][3]); *(LAS v2u*)(sl + 144 * lr + 32 * nd + 8 * fq) = w; }
#pragma unroll
        for (int t = 0; t < 2; ++t) { const v4u o = *(LAS const v4u*)(sl + 144 * ((lane >> 3) + 8 * t) + 16 * (lane & 7)); *(v4u*)(ut + (16 * ne + (lane >> 3) + 8 * t) * 64 + 8 * (lane & 7)) = o; }
    }
#else
#pragma unroll
    for (int nd = 0; nd < 4; ++nd)
#pragma unroll
        for (int ne = 0; ne < 4; ++ne) { v2u w; w.x = pk2(acc[nd][ne][0], acc[nd][ne][1]); w.y = pk2(acc[nd][ne][2], acc[nd][ne][3]);
            *(v2u*)(ut + (16 * ne + lr) * 64 + 16 * nd + 4 * fq) = w; }
#endif
}

template <int L, bool LAST = false> DI void tile_load(v4u (&r)[L / 8], const bf16_t* src, int lane) {
#pragma unroll
    for (int p = 0; p < L / 8; ++p) { const v4u* q_ = (const v4u*)(src + (size_t)(p * 8 + (lane >> 3)) * DIN + (lane & 7) * 8); r[p] = LAST ? LAST_USE_LD(q_) : *q_; }
}
template <int L> DI void tile_store(LAS bf16_t* dst, const v4u (&r)[L / 8], int lane) {
#pragma unroll
    for (int p = 0; p < L / 8; ++p) *(LAS v4u*)(dst + (p * 8 + (lane >> 3)) * 64 + (lane & 7) * 8) = r[p];
}

template <int L> DI void ret_pass1(const Args& a, LAS unsigned char* wl, int ch, int h, int lane_in) {
    int lane = lane_in; asm volatile("" : "+v"(lane));
    int row0, pos0, q, c; chunk_info(ch, row0, pos0, q, c);
    LAS bf16_t* kd = (LAS bf16_t*)wl; LAS bf16_t* vv = kd + 4096;
    const bf16_t* proj = (const bf16_t*)(a.ws + WS_PROJ) + (size_t)row0 * DIN;
    const float* rcos = (const float*)(a.ws + WS_ROPE); const float* rsin = rcos + 4096 * 32;
    const float lg2 = ret_log2g(h);
    v4u vraw[L / 8], kraw[L / 16][2]; f32x4 kcs[L / 16][4];
    tile_load<L>(vraw, proj + C_RV + h * 64, lane);
#pragma unroll
    for (int it = 0; it < L / 16; ++it) {
        const int idx = it * 64 + lane, s = idx >> 2, jb = (idx & 3) * 8;
        const bf16_t* kr = proj + (size_t)s * DIN + C_RK + h * 64;
        kraw[it][0] = *(const v4u*)(kr + jb); kraw[it][1] = *(const v4u*)(kr + 32 + jb);
        const float* cp = rcos + (size_t)(pos0 + s) * 32 + jb; const float* sp = rsin + (size_t)(pos0 + s) * 32 + jb;
        kcs[it][0] = *(const f32x4*)cp; kcs[it][1] = *(const f32x4*)(cp + 4); kcs[it][2] = *(const f32x4*)sp; kcs[it][3] = *(const f32x4*)(sp + 4);
    }
    __builtin_amdgcn_sched_barrier(0);
    tile_store<L>(vv, vraw, lane);
#pragma unroll
    for (int it = 0; it < L / 16; ++it) {
        const int idx = it * 64 + lane, s = idx >> 2, jb = (idx & 3) * 8;
        float k1[8], k2[8], o1[8], o2[8];
        unpack8(kraw[it][0], k1); unpack8(kraw[it][1], k2);
        const float cs[8] = {kcs[it][0][0], kcs[it][0][1], kcs[it][0][2], kcs[it][0][3], kcs[it][1][0], kcs[it][1][1], kcs[it][1][2], kcs[it][1][3]};
        const float sn[8] = {kcs[it][2][0], kcs[it][2][1], kcs[it][2][2], kcs[it][2][3], kcs[it][3][0], kcs[it][3][1], kcs[it][3][2], kcs[it][3][3]};
        const float sc = exp2f((float)(L - 1 - s) * lg2);
#pragma unroll
        for (int j = 0; j < 8; ++j) { o1[j] = (k1[j] * cs[j] - k2[j] * sn[j]) * sc; o2[j] = (k2[j] * cs[j] + k1[j] * sn[j]) * sc; }
        *(LAS bf16x8*)(kd + s * 64 + jb) = pack8(o1); *(LAS bf16x8*)(kd + s * 64 + 32 + jb) = pack8(o2);
    }
    ut_product<L>(vv, kd, (bf16_t*)(a.ws + WS_U) + ((size_t)ch * 8 + h) * 4096, lane);
}

DI float row_scan16(float x) {
    x += __builtin_bit_cast(float, __builtin_amdgcn_update_dpp(0, __builtin_bit_cast(int, x), 0x111, 0xf, 0xf, true));
    x += __builtin_bit_cast(float, __builtin_amdgcn_update_dpp(0, __builtin_bit_cast(int, x), 0x112, 0xf, 0xf, true));
    x += __builtin_bit_cast(float, __builtin_amdgcn_update_dpp(0, __builtin_bit_cast(int, x), 0x114, 0xf, 0xf, true));
    x += __builtin_bit_cast(float, __builtin_amdgcn_update_dpp(0, __builtin_bit_cast(int, x), 0x118, 0xf, 0xf, true));
    return x;
}
template <int NT> struct HgRaw { v4u hf[NT][2]; f32x4 cst[2][4]; };
template <int NT, int KP0 = 0, int KP1 = 2> DI void hg_load_raw(HgRaw<NT>& R, const Args& a, const bf16_t* proj, int layer, int h, int fq, int lr) {
#pragma unroll
    for (int kp = KP0; kp < KP1; ++kp) {
        const int d0 = h * 64 + 8 * fq + 32 * kp;
        const float* p0 = (const float*)(a.ws + WS_LBT) + layer * 256 + d0; const float* p2 = a.in[15] + layer * 256 + d0;
        R.cst[kp][0] = *(const f32x4*)p0; R.cst[kp][1] = *(const f32x4*)(p0 + 4); R.cst[kp][2] = *(const f32x4*)p2; R.cst[kp][3] = *(const f32x4*)(p2 + 4);
#pragma unroll
#if FRAG_PERM
        for (int t = 0; t < NT; ++t) R.hf[t][kp] = *(const v4u*)(proj + (size_t)(16 * t + FRAG_ROW((fq << 4) | lr)) * DIN + C_HF + h * 64 + 8 * FRAG_CHK((fq << 4) | lr) + 32 * kp);
#else
        for (int t = 0; t < NT; ++t) R.hf[t][kp] = *(const v4u*)(proj + (size_t)(16 * t + lr) * DIN + C_HF + d0);
#endif
    }
}
template <int NT, bool PACK, int KP0 = 0, int KP1 = 2> DI void hg_forget(const HgRaw<NT>& R, int layer, int fq, int lr, float (&cum)[NT][2][8], float (&kcf)[NT][2][8], bf16x8 (&Kc)[NT][2]) {
    const int lane = (fq << 4) | lr;
#pragma unroll
    for (int kp = KP0; kp < KP1; ++kp) {
        float lb[8], bs[8], car[8];
#pragma unroll
        for (int j = 0; j < 8; ++j) { lb[j] = R.cst[kp][j >> 2][j & 3]; bs[j] = R.cst[kp][2 + (j >> 2)][j & 3]; car[j] = 0.f; }
#pragma unroll
        for (int t = 0; t < NT; ++t) {
            float hf[8], kc[8];
#if FRAG_PERM
            unpack8(frag_perm(R.hf[t][kp], lane), hf);
#else
            unpack8(R.hf[t][kp], hf);
#endif
#pragma unroll
            for (int j = 0; j < 8; ++j) {
                const float z = hf[j] + bs[j];
                const float ez = fexp(-fminf(fmaxf(z, -30.f), 30.f));
                const float sg = frcp(1.f + ez);
                const float lf = __builtin_amdgcn_logf(fmaxf(lb[j] + (1.f - lb[j]) * sg, F_EPS));
                kc[j] = (1.f - lb[j]) * ez * sg;
                const float cl = row_scan16(lf) + car[j];
                cum[t][kp][j] = cl;
                if (t + 1 < NT) car[j] = sh_row15(cl, lane);
            }
            if (PACK) Kc[t][kp] = pack8(kc);
            else {
#pragma unroll
                for (int j = 0; j < 8; ++j) kcf[t][kp][j] = kc[j];
            }
        }
    }
}
template <int L> DI void hg_pass1(const Args& a, LAS unsigned char* wl, int layer, int ch, int h, int lane_in) {
    constexpr int NT = L / 16;
    int lane = lane_in; asm volatile("" : "+v"(lane));
    int row0, pos0, q, c; chunk_info(ch, row0, pos0, q, c);
    const int fq = lane >> 4, lr = lane & 15;
    LAS bf16_t* kd = (LAS bf16_t*)wl; LAS bf16_t* vv = kd + 4096;
    const bf16_t* proj = (const bf16_t*)(a.ws + WS_PROJ) + (size_t)row0 * DIN;
    float cum[NT][2][8]; bf16x8 Kc[NT][2];
    v4u vraw[L / 8];
    { HgRaw<NT> R; float (&kdummy)[NT][2][8] = *(float (*)[NT][2][8])nullptr;
      hg_load_raw<NT, 0, 1>(R, a, proj, layer, h, fq, lr); tile_load<L>(vraw, proj + C_HI + h * 64, lane);
      __builtin_amdgcn_sched_barrier(0);
      hg_load_raw<NT, 1, 2>(R, a, proj, layer, h, fq, lr);
      tile_store<L>(vv, vraw, lane);
      hg_forget<NT, true, 0, 1>(R, layer, fq, lr, cum, kdummy, Kc);
      __builtin_amdgcn_sched_barrier(0);
      hg_forget<NT, true, 1, 2>(R, layer, fq, lr, cum, kdummy, Kc); }
#pragma unroll
    for (int kp = 0; kp < 2; ++kp) {
        float cl[8];
#pragma unroll
        for (int j = 0; j < 8; ++j) cl[j] = sh_row15(cum[NT - 1][kp][j], lane);
        if (lr == 0) { float* clp = (float*)(a.ws + WS_CL) + (size_t)ch * 256 + h * 64 + 8 * fq + 32 * kp;
            *(f32x4*)clp = (f32x4){cl[0], cl[1], cl[2], cl[3]}; *(f32x4*)(clp + 4) = (f32x4){cl[4], cl[5], cl[6], cl[7]}; }
#pragma unroll
        for (int t = 0; t < NT; ++t) {
            float kc[8], o[8];
            unpack8(__builtin_bit_cast(v4u, Kc[t][kp]), kc);
#pragma unroll
            for (int j = 0; j < 8; ++j) o[j] = kc[j] * __builtin_amdgcn_exp2f(cl[j] - cum[t][kp][j]);
            *(LAS bf16x8*)(kd + (16 * t + lr) * 64 + 8 * fq + 32 * kp) = pack8(o);
        }
    }
    ut_product<L>(vv, kd, (bf16_t*)(a.ws + WS_U) + ((size_t)ch * 8 + 4 + h) * 4096, lane);
}

template <int L> DI void rg_pass1(const Args& a, LAS unsigned char* wl, int layer, int ch, int g, int lane_in) {
    constexpr int NT = L / 16;
    int lane = lane_in; asm volatile("" : "+v"(lane));
#if PROBE_PK
    {
        float s0 = (float)lane, s1 = s0 + 1.f, s2 = s0 + 2.f, s3 = s0 + 3.f, s4 = s0 + 4.f, s5 = s0 + 5.f, s6 = s0 + 6.f, s7 = s0 + 7.f; const float c1 = 0.999f, c2 = 0.001f;
        f32x2 p0 = {s0, s1}, p1 = {s2, s3}, p2 = {s4, s5}, p3 = {s6, s7}; const f32x2 q1 = {c1, c1}, q2 = {c2, c2};
#pragma unroll 1
        for (int rep = 0; rep < 256; ++rep) {
            if (PROBE_PK == 1) asm volatile("v_fma_f32 %0, %0, %8, %9\n\tv_fma_f32 %1, %1, %8, %9\n\tv_fma_f32 %2, %2, %8, %9\n\tv_fma_f32 %3, %3, %8, %9\n\tv_fma_f32 %4, %4, %8, %9\n\tv_fma_f32 %5, %5, %8, %9\n\tv_fma_f32 %6, %6, %8, %9\n\tv_fma_f32 %7, %7, %8, %9"
                : "+v"(s0), "+v"(s1), "+v"(s2), "+v"(s3), "+v"(s4), "+v"(s5), "+v"(s6), "+v"(s7) : "v"(c1), "v"(c2));
            else asm volatile("v_pk_fma_f32 %0, %0, %4, %5\n\tv_pk_fma_f32 %1, %1, %4, %5\n\tv_pk_fma_f32 %2, %2, %4, %5\n\tv_pk_fma_f32 %3, %3, %4, %5"
                : "+v"(p0), "+v"(p1), "+v"(p2), "+v"(p3) : "v"(q1), "v"(q2));
        }
        const float sink = (s0 + s1 + s2 + s3) + (s4 + s5 + s6 + s7) + (p0[0] + p0[1] + p1[0] + p1[1]) + (p2[0] + p2[1] + p3[0] + p3[1]);
        if (sink == 123456.75f) ((float*)(a.ws + WS_LS))[2001] = sink;
    }
#endif
    int row0, pos0, q, c; chunk_info(ch, row0, pos0, q, c);
    const int fq = lane >> 4, lr = lane & 15;
    const bf16_t* projx = (const bf16_t*)(a.ws + WS_PROJ) + (size_t)row0 * DIN + C_RGX + g * 64;
    const float* cw = a.in[7] + (size_t)layer * 4 * 512 + g * 64; const float* cbp = a.in[8] + (size_t)layer * 512 + g * 64;
    const bool prev_rows = (ch < 256) && (c > 0), is_sample = ch >= 256;
    const float* cache = a.in[2] + ((size_t)layer * 16 + (is_sample ? q - NB : 0)) * 3 * 512 + g * 64;
    bf16x8 Af[NT][2];
#if RG_STAGE
    {
        constexpr int NR = L + 3, NP = (NR + 7) / 8;
        v4u sraw[NP]; float cv[8];
#pragma unroll
        for (int p = 0; p < NP; ++p) { const int r = p * 8 + (lane >> 3), tt = r - 3; const bool ok = (tt >= 0 || prev_rows) && r < NR;
            sraw[p] = LAST_USE_LD((const v4u*)(projx + (ptrdiff_t)(ok ? tt : 0) * DIN + (lane & 7) * 8)); }
#pragma unroll
        for (int e = 0; e < 8; ++e) cv[e] = 0.f;
        if (is_sample) { const int r = lane >> 3; load8f(cache + (size_t)(r < 3 ? r : 0) * 512 + (lane & 7) * 8, cv); }
        __builtin_amdgcn_sched_barrier(0);
#pragma unroll
        for (int p = 0; p < NP; ++p) { const int r = p * 8 + (lane >> 3);
            v4u v = sraw[p];
            if (p == 0) { const bool inrow = r >= 3 || prev_rows; const bf16x8 cb8 = pack8(cv); const v4u cvu = __builtin_bit_cast(v4u, cb8);
                v.x = inrow ? v.x : cvu.x; v.y = inrow ? v.y : cvu.y; v.z = inrow ? v.z : cvu.z; v.w = inrow ? v.w : cvu.w; }
            if (r < NR) *(LAS v4u*)(wl + r * 144 + (lane & 7) * 16) = v; }
    }
#pragma unroll
    for (int kp = 0; kp < 2; ++kp) {
        const int cin0 = 8 * fq + 32 * kp;
        float w0[8], w1[8], w2[8], w3[8], cb[8];
        load8f(cw + 0 * 512 + cin0, w0); load8f(cw + 1 * 512 + cin0, w1); load8f(cw + 2 * 512 + cin0, w2); load8f(cw + 3 * 512 + cin0, w3); load8f(cbp + cin0, cb);
#pragma unroll
        for (int m = 0; m < NT; ++m) {
            float x[4][8];
#pragma unroll
            for (int j = 0; j < 4; ++j) unpack8(*(LAS const v4u*)(wl + (16 * m + lr + j) * 144 + (fq + 4 * kp) * 16), x[j]);
            float u[8];
#pragma unroll
            for (int e = 0; e < 8; ++e) u[e] = cb[e] + w0[e] * x[0][e] + w1[e] * x[1][e] + w2[e] * x[2][e] + w3[e] * x[3][e];
            Af[m][kp] = pack8(u);
        }
    }
#else
#pragma unroll
    for (int kp = 0; kp < 2; ++kp) {
        const int cin0 = 8 * fq + 32 * kp;
        v4u raw[NT][4]; float xb[3][8];
#pragma unroll
        for (int m = 0; m < NT; ++m)
#pragma unroll
            for (int j = 0; j < 4; ++j) {
                const int tt = 16 * m + lr - 3 + j;
                const bool inrow = (m > 0) || tt >= 0 || prev_rows;
                raw[m][j] = *(const v4u*)(projx + (ptrdiff_t)(inrow ? tt : 0) * DIN + cin0);
            }
#pragma unroll
        for (int j = 0; j < 3; ++j) { const int tt = lr - 3 + j; load8f(cache + (size_t)(tt < 0 ? 3 + tt : 0) * 512 + cin0, xb[j]); }
        float w0[8], w1[8], w2[8], w3[8], cb[8];
        load8f(cw + 0 * 512 + cin0, w0); load8f(cw + 1 * 512 + cin0, w1); load8f(cw + 2 * 512 + cin0, w2); load8f(cw + 3 * 512 + cin0, w3); load8f(cbp + cin0, cb);
#pragma unroll
        for (int m = 0; m < NT; ++m) {
            float x[4][8];
#pragma unroll
            for (int j = 0; j < 4; ++j) {
                unpack8(raw[m][j], x[j]);
                if (m == 0 && j < 3) { const int tt = lr - 3 + j; const bool inrow = tt >= 0 || prev_rows;
#pragma unroll
                    for (int e = 0; e < 8; ++e) x[j][e] = inrow ? x[j][e] : (is_sample ? xb[j][e] : 0.f); }
            }
            float u[8];
#pragma unroll
            for (int e = 0; e < 8; ++e) u[e] = cb[e] + w0[e] * x[0][e] + w1[e] * x[1][e] + w2[e] * x[2][e] + w3[e] * x[3][e];
            Af[m][kp] = pack8(u);
        }
        if (kp == 0) __builtin_amdgcn_sched_barrier(0);
    }
#endif
#if PROBE_MFMA
    {
        f32x4 d0 = {0.f, 0.f, 0.f, 0.f}, d1 = d0, d2 = d0, d3 = d0;
#pragma unroll 1
        for (int rep = 0; rep < PROBE_MFMA / 4; ++rep) {
            d0 = MFMA16(Af[0][0], Af[1][0], d0); d1 = MFMA16(Af[0][1], Af[1][1], d1); d2 = MFMA16(Af[1][0], Af[0][0], d2); d3 = MFMA16(Af[1][1], Af[0][1], d3);
        }
        const f32x4 ds = d0 + d1 + d2 + d3; asm volatile("" :: "v"(ds[0] + ds[1] + ds[2] + ds[3]));
    }
#endif
    bf16x8 idc[2], idt[2];
#pragma unroll
    for (int p = 0; p < 2; ++p)
#pragma unroll
        for (int j = 0; j < 8; ++j) { idc[p][j] = (16 * p + lr - 8 * fq == j) ? (short)0x3F80 : (short)0; idt[p][j] = ((j >> 2) == p && (j & 3) == lr - 4 * fq) ? (short)0x3F80 : (short)0; }
    const bf16_t* gw = (const bf16_t*)(a.ws + WS_GATEW) + ((size_t)(layer * 2) * 8 + g) * 4096;
    bf16_t* Pout = (bf16_t*)(a.ws + WS_P) + (size_t)row0 * 512 + g * 64;
    bf16_t* Hout = (bf16_t*)(a.ws + WS_HL) + (size_t)row0 * 512 + g * 64;
    bf16x8 nya0, nya1, nyx0, nyx1; float nbac, nbxc, nls;
#if FRAG_PERM3
#define RG_WOFF(n_) ((size_t)(16 * (n_) + FRAG_ROW(lane)) * 64 + 8 * FRAG_CHK(lane))
#else
#define RG_WOFF(n_) ((size_t)(16 * (n_) + lr) * 64 + 8 * fq)
#endif
#define RG_LOADW(n_) do { const int cc_ = 16 * (n_) + lr, chn_ = g * 64 + cc_; \
        nya0 = *(const bf16x8*)(gw + RG_WOFF(n_)); nya1 = *(const bf16x8*)(gw + RG_WOFF(n_) + 32); \
        nyx0 = *(const bf16x8*)(gw + 8 * 4096 + RG_WOFF(n_)); nyx1 = *(const bf16x8*)(gw + 8 * 4096 + RG_WOFF(n_) + 32); \
        nbac = -1.4426950408889634f * a.in[10][layer * 512 + chn_]; nbxc = -1.4426950408889634f * a.in[12][layer * 512 + chn_]; nls = ((const float*)(a.ws + WS_LS))[layer * 512 + chn_]; } while (0)
    RG_LOADW(0);
#pragma unroll 1
    for (int n = 0; n < 4; ++n) {
        const int cc = 16 * n + lr, chn = g * 64 + cc;
#if FRAG_PERM3
        const bf16x8 ya0 = frag_perm8(nya0, lane), ya1 = frag_perm8(nya1, lane), yx0 = frag_perm8(nyx0, lane), yx1 = frag_perm8(nyx1, lane);
#else
        const bf16x8 ya0 = nya0, ya1 = nya1, yx0 = nyx0, yx1 = nyx1;
#endif
        const float bac = nbac, bxc = nbxc, ls = nls;
        RG_LOADW(n < 3 ? n + 1 : 3);
        const bf16x8 idn = (n & 1) ? idc[1] : idc[0];
        float Arun = 1.f, Brun = 0.f;
        float Al[NT][4], Bl[NT][4];
#pragma unroll
        for (int m = 0; m < NT; ++m) {
            f32x4 accr = (f32x4){0.f, 0.f, 0.f, 0.f}, accx = accr, accu = accr;
            accr = MFMA16(Af[m][0], ya0, accr); accr = MFMA16(Af[m][1], ya1, accr);
            accx = MFMA16(Af[m][0], yx0, accx); accx = MFMA16(Af[m][1], yx1, accx);
            accu = (n & 2) ? MFMA16(Af[m][1], idn, accu) : MFMA16(Af[m][0], idn, accu);
            float omv[4], avv[4], giu[4], xmin = 0.f;
#pragma unroll
            for (int r = 0; r < 4; ++r) {
                const float rr = frcp(1.f + __builtin_amdgcn_exp2f(accr[r] + bac)), gi = frcp(1.f + __builtin_amdgcn_exp2f(accx[r] + bxc));
                const float x2 = rr * ls;
                const float av = __builtin_amdgcn_exp2f(x2 * 0.72134752044448170f);
                float om = -x2 * (1.f + x2 * (0.5f + x2 * (1.f / 6.f + x2 * (1.f / 24.f))));
                xmin = fminf(xmin, x2); omv[r] = om; avv[r] = av; giu[r] = gi * accu[r];
            }
            if (__builtin_amdgcn_ballot_w64(xmin < -0.25f) != 0ull) {
#pragma unroll
                for (int r = 0; r < 4; ++r) omv[r] = (omv[r] > 0.2212f) ? __builtin_fmaf(-avv[r], avv[r], 1.f) : omv[r];
            }
#pragma unroll
            for (int r = 0; r < 4; ++r) {
                const float av = avv[r], bv = __builtin_amdgcn_sqrtf(omv[r]) * giu[r];
                if (r == 0) { Al[m][0] = av; Bl[m][0] = bv; } else { Al[m][r] = av * Al[m][r - 1]; Bl[m][r] = av * Bl[m][r - 1] + bv; }
            }
        }
        float A4[NT], B4[NT], PA[NT], PB[NT];
#pragma unroll
        for (int m = 0; m < NT; ++m) { A4[m] = Al[m][3]; B4[m] = Bl[m][3]; }
        { float Ap[NT], Bp[NT]; const bool od = (fq & 1) != 0;
#pragma unroll
          for (int m = 0; m < NT; ++m) { Ap[m] = shx(A4[m], 16, lane); Bp[m] = shx(B4[m], 16, lane); }
#pragma unroll
          for (int m = 0; m < NT; ++m) { PA[m] = od ? Ap[m] : 1.f; PB[m] = od ? Bp[m] : 0.f;
              B4[m] = (od ? Bp[m] : B4[m]) * (od ? A4[m] : Ap[m]) + (od ? B4[m] : Bp[m]); A4[m] = A4[m] * Ap[m]; } }
        { float Ap[NT], Bp[NT]; const bool od = (fq & 2) != 0;
#pragma unroll
          for (int m = 0; m < NT; ++m) { Ap[m] = shx(A4[m], 32, lane); Bp[m] = shx(B4[m], 32, lane); }
#pragma unroll
          for (int m = 0; m < NT; ++m) { PB[m] = od ? Bp[m] * PA[m] + PB[m] : PB[m]; PA[m] = od ? Ap[m] * PA[m] : PA[m];
              B4[m] = (od ? Bp[m] : B4[m]) * (od ? A4[m] : Ap[m]) + (od ? B4[m] : Bp[m]); A4[m] = A4[m] * Ap[m]; } }
#pragma unroll
        for (int kt = 0; kt < NT / 2; ++kt) {
            float Pv[8], Hv[8];
#pragma unroll
            for (int hh = 0; hh < 2; ++hh) {
                const int m = 2 * kt + hh;
                const float PAin = PA[m] * Arun, PBin = PA[m] * Brun + PB[m];
#pragma unroll
                for (int r = 0; r < 4; ++r) { Pv[4 * hh + r] = Al[m][r] * PAin; Hv[4 * hh + r] = Al[m][r] * PBin + Bl[m][r]; }
                Brun = A4[m] * Brun + B4[m]; Arun = A4[m] * Arun;
            }
            const bf16x8 Xp = pack8(Pv), Xh = pack8(Hv);
#pragma unroll
            for (int hh = 0; hh < 2; ++hh) {
                const int tp = 16 * (2 * kt + hh) + lr;
                f32x4 z = (f32x4){0.f, 0.f, 0.f, 0.f};
                const f32x4 op = MFMA16(Xp, idt[hh], z), oh = MFMA16(Xh, idt[hh], z);
                v2u wp, wh; wp.x = pk2(op[0], op[1]); wp.y = pk2(op[2], op[3]); wh.x = pk2(oh[0], oh[1]); wh.y = pk2(oh[2], oh[3]);
#if RG_STORE_XPOSE
                {
                    LAS unsigned char* sl = wl + ((2 * kt + hh) * 2) * 640; (void)tp;
                    *(LAS v2u*)(sl + 40 * lr + 8 * fq) = wp; *(LAS v2u*)(sl + 640 + 40 * lr + 8 * fq) = wh;
                    const v2u wpt = *(LAS const v2u*)(sl + 40 * (lane >> 2) + 8 * (lane & 3)), wht = *(LAS const v2u*)(sl + 640 + 40 * (lane >> 2) + 8 * (lane & 3));
                    const int tq = 16 * (2 * kt + hh) + (lane >> 2);
                    *(v2u*)(Pout + (size_t)tq * 512 + 16 * n + 4 * (lane & 3)) = wpt; *(v2u*)(Hout + (size_t)tq * 512 + 16 * n + 4 * (lane & 3)) = wht; }
#else
                *(v2u*)(Pout + (size_t)tp * 512 + 16 * n + 4 * fq) = wp; *(v2u*)(Hout + (size_t)tp * 512 + 16 * n + 4 * fq) = wh;
#endif
            }
        }
        if (fq == 0) { ((float*)(a.ws + WS_RGA))[(size_t)ch * 512 + chn] = Arun; ((float*)(a.ws + WS_RGB))[(size_t)ch * 512 + chn] = Brun; }
    }
#undef RG_LOADW
}

template <int L> DI void rg_pass2(const Args& a, int layer, int ch, int g, int lane_in) {
    int lane = lane_in; asm volatile("" : "+v"(lane));
    int row0, pos0, q, c; chunk_info(ch, row0, pos0, q, c);
    const int rr = lane >> 3, c0 = (lane & 7) * 8;
    float hs[8]; load8f((const float*)(a.ws + WS_HST) + (size_t)ch * 512 + g * 64 + c0, hs);
    const bf16_t* Pp = (const bf16_t*)(a.ws + WS_P) + (size_t)row0 * 512 + g * 64 + c0;
    const bf16_t* Hp = (const bf16_t*)(a.ws + WS_HL) + (size_t)row0 * 512 + g * 64 + c0;
    const bf16_t* Gp = (const bf16_t*)(a.ws + WS_PROJ) + (size_t)row0 * DIN + C_RGG + g * 64 + c0;
    bf16_t* ymix = (bf16_t*)(a.ws + WS_YMIX) + (size_t)row0 * D + g * 64 + c0;
    v4u praw[L / 8], hraw[L / 8], graw[L / 8];
#pragma unroll
    for (int it = 0; it < L / 8; ++it) { const int t = it * 8 + rr;
#if LAST_USE_NT
            praw[it] = __builtin_nontemporal_load((const v4u*)(Pp + (size_t)t * 512)); hraw[it] = __builtin_nontemporal_load((const v4u*)(Hp + (size_t)t * 512)); graw[it] = __builtin_nontemporal_load((const v4u*)(Gp + (size_t)t * DIN)); }
#else
            praw[it] = *(const v4u*)(Pp + (size_t)t * 512); hraw[it] = *(const v4u*)(Hp + (size_t)t * 512); graw[it] = *(const v4u*)(Gp + (size_t)t * DIN); }
#endif

    __builtin_amdgcn_sched_barrier(0);
#pragma unroll
    for (int it = 0; it < L / 8; ++it) {
        const int t = it * 8 + rr;
        float pv[8], hv[8], gv[8], y[8];
        unpack8(praw[it], pv); unpack8(hraw[it], hv); unpack8(graw[it], gv);
#pragma unroll
        for (int j = 0; j < 8; ++j) y[j] = (hv[j] + pv[j] * hs[j]) * gv[j] * sigmoidf_(gv[j]);
        *(bf16x8*)(ymix + (size_t)t * D) = pack8(y);
    }
}

template <int L> DI void ret_pass2(const Args& a, LAS unsigned char* wl, int layer, int ch, int h, int lane_in) {
    int lane = lane_in; asm volatile("" : "+v"(lane));
    constexpr int NT = L / 16, KS = L / 32;
    int row0, pos0, q, c; chunk_info(ch, row0, pos0, q, c);
    const int fq = lane >> 4, lr = lane & 15;
    LAS bf16_t* vv = (LAS bf16_t*)wl;
    const bf16_t* proj = (const bf16_t*)(a.ws + WS_PROJ) + (size_t)row0 * DIN;
    const float* rcos = (const float*)(a.ws + WS_ROPE); const float* rsin = rcos + 4096 * 32;
    const bf16_t* st = (const bf16_t*)(a.ws + WS_ST) + ((size_t)ch * 8 + h) * 4096;
    const float* gnp = a.in[14] + layer * 256 + h * 64 + 4 * fq;
    bf16_t* ymix = (bf16_t*)(a.ws + WS_YMIX) + (size_t)row0 * D + 512 + h * 64;
    const float lg2 = ret_log2g(h);
    v4u vraw[L / 8], kraw[NT][2]; f32x4 kcs[NT][4]; bf16x8 Sf[4][2]; f32x4 gq[4];
#pragma unroll
    for (int p = 0; p < L / 8; ++p) vraw[p] = LAST_USE_LD((const v4u*)(proj + (size_t)(p * 8 + (lane >> 3)) * DIN + C_RV + h * 64 + (lane & 7) * 8));
#pragma unroll
    for (int t = 0; t < NT; ++t) { const int s = 16 * t + lr;
#if FRAG_PERM2
        const bf16_t* kr = proj + (size_t)(16 * t + FRAG_ROW(lane)) * DIN + C_RK + h * 64 + 8 * FRAG_CHK(lane);
#else
        const bf16_t* kr = proj + (size_t)s * DIN + C_RK + h * 64 + 8 * fq;
#endif
        kraw[t][0] = *(const v4u*)kr; kraw[t][1] = *(const v4u*)(kr + 32);
        const float* cp = rcos + (size_t)(pos0 + s) * 32 + 8 * fq; const float* sp = rsin + (size_t)(pos0 + s) * 32 + 8 * fq;
        kcs[t][0] = *(const f32x4*)cp; kcs[t][1] = *(const f32x4*)(cp + 4); kcs[t][2] = *(const f32x4*)sp; kcs[t][3] = *(const f32x4*)(sp + 4); }
#pragma unroll
#if FRAG_PERM
    for (int ne = 0; ne < 4; ++ne) { Sf[ne][0] = *(const bf16x8*)(st + (16 * ne + FRAG_ROW(lane)) * 64 + 8 * FRAG_CHK(lane)); Sf[ne][1] = *(const bf16x8*)(st + (16 * ne + FRAG_ROW(lane)) * 64 + 32 + 8 * FRAG_CHK(lane)); gq[ne] = *(const f32x4*)(gnp + 16 * ne); }
    __builtin_amdgcn_sched_barrier(0);
#pragma unroll
    for (int ne = 0; ne < 4; ++ne) { Sf[ne][0] = frag_perm8(Sf[ne][0], lane); Sf[ne][1] = frag_perm8(Sf[ne][1], lane); }
#else
    for (int ne = 0; ne < 4; ++ne) { Sf[ne][0] = *(const bf16x8*)(st + (16 * ne + lr) * 64 + 8 * fq); Sf[ne][1] = *(const bf16x8*)(st + (16 * ne + lr) * 64 + 32 + 8 * fq); gq[ne] = *(const f32x4*)(gnp + 16 * ne); }
    __builtin_amdgcn_sched_barrier(0);
#endif
#pragma unroll
    for (int p = 0; p < L / 8; ++p) *(LAS v4u*)(vv + (p * 8 + (lane >> 3)) * 64 + (lane & 7) * 8) = vraw[p];
    bf16x8 Kf[NT][2];
#pragma unroll
    for (int t = 0; t < NT; ++t) {
        const int s = 16 * t + lr;
        float k1[8], k2[8], o1[8], o2[8];
#if FRAG_PERM2
        unpack8(frag_perm(kraw[t][0], lane), k1); unpack8(frag_perm(kraw[t][1], lane), k2);
#else
        unpack8(kraw[t][0], k1); unpack8(kraw[t][1], k2);
#endif
        const float cs[8] = {kcs[t][0][0], kcs[t][0][1], kcs[t][0][2], kcs[t][0][3], kcs[t][1][0], kcs[t][1][1], kcs[t][1][2], kcs[t][1][3]};
        const float sn[8] = {kcs[t][2][0], kcs[t][2][1], kcs[t][2][2], kcs[t][2][3], kcs[t][3][0], kcs[t][3][1], kcs[t][3][2], kcs[t][3][3]};
        const float gk = exp2f(-(float)(s + 1) * lg2);
#pragma unroll
        for (int j = 0; j < 8; ++j) { o1[j] = (k1[j] * cs[j] - k2[j] * sn[j]) * gk; o2[j] = (k2[j] * cs[j] + k1[j] * sn[j]) * gk; }
        Kf[t][0] = pack8(o1); Kf[t][1] = pack8(o2);
    }
    v4u qraw[2]; f32x4 qcs[4]; v2u graw[4];
#if FRAG_PERM2
#define RET_QPTR(b_) (proj + (size_t)(16 * (b_) + FRAG_ROW(lane)) * DIN + C_RQ + h * 64 + 8 * FRAG_CHK(lane))
#else
#define RET_QPTR(b_) (proj + (size_t)(16 * (b_) + lr) * DIN + C_RQ + h * 64 + 8 * fq)
#endif
#define RET_LOADQ(b_) do { const int l_ = 16 * (b_) + lr; const bf16_t* qr_ = RET_QPTR(b_); \
        qraw[0] = *(const v4u*)qr_; qraw[1] = *(const v4u*)(qr_ + 32); \
        const float* cp_ = rcos + (size_t)(pos0 + l_) * 32 + 8 * fq; const float* sp_ = rsin + (size_t)(pos0 + l_) * 32 + 8 * fq; \
        qcs[0] = *(const f32x4*)cp_; qcs[1] = *(const f32x4*)(cp_ + 4); qcs[2] = *(const f32x4*)sp_; qcs[3] = *(const f32x4*)(sp_ + 4); \
        _Pragma("unroll") for (int ne_ = 0; ne_ < 4; ++ne_) graw[ne_] = *(const v2u*)(proj + (size_t)l_ * DIN + C_RG + h * 64 + 16 * ne_ + 4 * fq); } while (0)
    RET_LOADQ(0);
#pragma unroll 1
    for (int b = 0; b < NT; ++b) {
        const int l = 16 * b + lr;
        const v4u q0 = qraw[0], q1r = qraw[1]; const f32x4 c0 = qcs[0], c1 = qcs[1], s0 = qcs[2], s1 = qcs[3]; const v2u g0r = graw[0], g1r = graw[1], g2r = graw[2], g3r = graw[3];
        RET_LOADQ(b + 1 < NT ? b + 1 : b);
        __builtin_amdgcn_sched_barrier(0);
        bf16x8 Qh[2];
        {
            float q1[8], q2[8], o1[8], o2[8];
#if FRAG_PERM2
            unpack8(frag_perm(q0, lane), q1); unpack8(frag_perm(q1r, lane), q2);
#else
            unpack8(q0, q1); unpack8(q1r, q2);
#endif
            const float cs[8] = {c0[0], c0[1], c0[2], c0[3], c1[0], c1[1], c1[2], c1[3]}, sn[8] = {s0[0], s0[1], s0[2], s0[3], s1[0], s1[1], s1[2], s1[3]};
            const float gl = 0.125f * exp2f((float)(l + 1) * lg2);
#pragma unroll
            for (int j = 0; j < 8; ++j) { o1[j] = gl * (q1[j] * cs[j] - q2[j] * sn[j]); o2[j] = gl * (q2[j] * cs[j] + q1[j] * sn[j]); }
            Qh[0] = pack8(o1); Qh[1] = pack8(o2);
        }
        f32x4 sc[NT];
#pragma unroll
        for (int t = 0; t < NT; ++t) {
            sc[t] = (f32x4){0.f, 0.f, 0.f, 0.f};
            if (t <= b) {
                sc[t] = MFMA16(Kf[t][0], Qh[0], sc[t]); sc[t] = MFMA16(Kf[t][1], Qh[1], sc[t]);
                if (t == b) {
#pragma unroll
                    for (int r = 0; r < 4; ++r) if (4 * fq + r > lr) sc[t][r] = 0.f;
                }
            }
        }
        f32x4 O[4];
#pragma unroll
        for (int ne = 0; ne < 4; ++ne) { O[ne] = (f32x4){0.f, 0.f, 0.f, 0.f}; O[ne] = MFMA16(Sf[ne][0], Qh[0], O[ne]); O[ne] = MFMA16(Sf[ne][1], Qh[1], O[ne]); }
#pragma unroll
        for (int ks = 0; ks < KS; ++ks) {
            if (2 * ks <= b) {
                const float pv[8] = {sc[2 * ks][0], sc[2 * ks][1], sc[2 * ks][2], sc[2 * ks][3], sc[2 * ks + 1][0], sc[2 * ks + 1][1], sc[2 * ks + 1][2], sc[2 * ks + 1][3]};
                const bf16x8 Pf = pack8(pv);
#pragma unroll
                for (int ne = 0; ne < 4; ++ne) O[ne] = MFMA16(tr_frag(vv, 32 * ks, 16 * ne, lane), Pf, O[ne]);
            }
        }
        float sm = 0.f;
#pragma unroll
        for (int ne = 0; ne < 4; ++ne) sm += (O[ne][0] + O[ne][1]) + (O[ne][2] + O[ne][3]);
        sm += shx(sm, 16, lane); sm += shx(sm, 32, lane);
        const float mu = sm * (1.f / 64.f);
        float vq = 0.f;
#pragma unroll
        for (int ne = 0; ne < 4; ++ne)
#pragma unroll
            for (int r = 0; r < 4; ++r) { const float dl = O[ne][r] - mu; vq += dl * dl; }
        vq += shx(vq, 16, lane); vq += shx(vq, 32, lane);
        const float rstd = rsqrtf(vq * (1.f / 64.f) + LN_EPS);
        const v2u gr[4] = {g0r, g1r, g2r, g3r};
#pragma unroll
        for (int ne = 0; ne < 4; ++ne) {
            const v2u gw = gr[ne];
            const float g0 = __uint_as_float(gw.x << 16), g1 = __uint_as_float(gw.x & 0xffff0000u), g2 = __uint_as_float(gw.y << 16), g3 = __uint_as_float(gw.y & 0xffff0000u);
            const float y0 = (O[ne][0] - mu) * rstd * gq[ne][0] * g0 * sigmoidf_(g0), y1 = (O[ne][1] - mu) * rstd * gq[ne][1] * g1 * sigmoidf_(g1);
            const float y2 = (O[ne][2] - mu) * rstd * gq[ne][2] * g2 * sigmoidf_(g2), y3 = (O[ne][3] - mu) * rstd * gq[ne][3] * g3 * sigmoidf_(g3);
            v2u o; o.x = pk2(y0, y1); o.y = pk2(y2, y3);
            *(v2u*)(ymix + (size_t)l * D + 16 * ne + 4 * fq) = o;
        }
    }
#undef RET_LOADQ
}

template <int L> DI void hg_pass2(const Args& a, LAS unsigned char* wl, int layer, int ch, int h, int lane_in) {
    constexpr int NT = L / 16, KS = L / 32;
    int lane = lane_in; asm volatile("" : "+v"(lane));
    int row0, pos0, q, c; chunk_info(ch, row0, pos0, q, c);
    const int fq = lane >> 4, lr = lane & 15;
    LAS bf16_t* vv = (LAS bf16_t*)wl;
    const bf16_t* proj = (const bf16_t*)(a.ws + WS_PROJ) + (size_t)row0 * DIN;
    const bf16_t* st = (const bf16_t*)(a.ws + WS_ST) + ((size_t)ch * 8 + 4 + h) * 4096;
    const float* gnp = a.in[17] + layer * 256 + h * 64 + 4 * fq;
    bf16_t* ymix = (bf16_t*)(a.ws + WS_YMIX) + (size_t)row0 * D + 768 + h * 64;
    float cum[NT][2][8]; bf16x8 Kc[NT][2];
    {
        v4u vraw[L / 8]; HgRaw<NT> R; float (&kdummy)[NT][2][8] = *(float (*)[NT][2][8])nullptr;
        tile_load<L, true>(vraw, proj + C_HI + h * 64, lane); hg_load_raw<NT, 0, 1>(R, a, proj, layer, h, fq, lr);
        __builtin_amdgcn_sched_barrier(0);
        hg_load_raw<NT, 1, 2>(R, a, proj, layer, h, fq, lr);
        tile_store<L>(vv, vraw, lane);
        hg_forget<NT, true, 0, 1>(R, layer, fq, lr, cum, kdummy, Kc);
        __builtin_amdgcn_sched_barrier(0);
        hg_forget<NT, true, 1, 2>(R, layer, fq, lr, cum, kdummy, Kc);
    }
    LAS bf16x8* kcL = (LAS bf16x8*)(wl + 8192);
#pragma unroll
    for (int t = 0; t < NT; ++t) { kcL[(2 * t) * 64 + lane] = Kc[t][0]; kcL[(2 * t + 1) * 64 + lane] = Kc[t][1]; }
    v4u qraw[NT][2]; v2u graw[NT][4];
#if FRAG_PERM2
#define HG_QPTR(b_) (proj + (size_t)(16 * (b_) + FRAG_ROW(lane)) * DIN + C_HQ + h * 64 + 8 * FRAG_CHK(lane))
#else
#define HG_QPTR(b_) (proj + (size_t)(16 * (b_) + lr) * DIN + C_HQ + h * 64 + 8 * fq)
#endif
#define HG_LOADQ(b_) do { const int t_ = 16 * (b_) + lr; \
        qraw[b_][0] = *(const v4u*)(HG_QPTR(b_)); qraw[b_][1] = *(const v4u*)(HG_QPTR(b_) + 32); \
        _Pragma("unroll") for (int ne_ = 0; ne_ < 4; ++ne_) graw[b_][ne_] = *(const v2u*)(proj + (size_t)t_ * DIN + C_HG + h * 64 + 16 * ne_ + 4 * fq); } while (0)
#pragma unroll
    for (int b = 0; b < NT; ++b) {
        const int t = 16 * b + lr;
        HG_LOADQ(b);
        bf16x8 Sf[4][2];
#pragma unroll
#if FRAG_PERM
        for (int ne = 0; ne < 4; ++ne) { Sf[ne][0] = *(const bf16x8*)(st + (16 * ne + FRAG_ROW(lane)) * 64 + 8 * FRAG_CHK(lane)); Sf[ne][1] = *(const bf16x8*)(st + (16 * ne + FRAG_ROW(lane)) * 64 + 32 + 8 * FRAG_CHK(lane)); }
#else
        for (int ne = 0; ne < 4; ++ne) { Sf[ne][0] = *(const bf16x8*)(st + (16 * ne + lr) * 64 + 8 * fq); Sf[ne][1] = *(const bf16x8*)(st + (16 * ne + lr) * 64 + 32 + 8 * fq); }
#endif
        f32x4 gq[4];
#pragma unroll
        for (int ne = 0; ne < 4; ++ne) gq[ne] = *(const f32x4*)(gnp + 16 * ne);
        __builtin_amdgcn_sched_barrier(0);
        float Rb[2][8];
        bf16x8 Qt[2], Qh[2];
#pragma unroll
        for (int kp = 0; kp < 2; ++kp) {
            float qv[8], o1[8], o2[8];
#if FRAG_PERM2
            unpack8(frag_perm(qraw[b][kp], lane), qv);
#else
            unpack8(qraw[b][kp], qv);
#endif
#pragma unroll
            for (int j = 0; j < 8; ++j) {
                Rb[kp][j] = b > 0 ? sh_row15(cum[b > 0 ? b - 1 : 0][kp][j], lane) : 0.f;
                o1[j] = qv[j] * __builtin_amdgcn_exp2f(cum[b][kp][j] - Rb[kp][j]); o2[j] = qv[j] * __builtin_amdgcn_exp2f(cum[b][kp][j]);
            }
            Qt[kp] = pack8(o1); Qh[kp] = pack8(o2);
        }
        f32x4 O[4];
#pragma unroll
        for (int ne = 0; ne < 4; ++ne) O[ne] = (f32x4){0.f, 0.f, 0.f, 0.f};
#pragma unroll
        for (int ks = 0; ks < KS; ++ks) {
            if (2 * ks <= b) {
                f32x4 sc[2];
#pragma unroll
                for (int hh = 0; hh < 2; ++hh) {
                    const int tt = 2 * ks + hh;
                    sc[hh] = (f32x4){0.f, 0.f, 0.f, 0.f};
                    if (tt <= b) {
#pragma unroll
                        for (int kp = 0; kp < 2; ++kp) {
                            float kc[8], o1[8];
                            unpack8(__builtin_bit_cast(v4u, kcL[(2 * (tt < NT ? tt : 0) + kp) * 64 + lane]), kc);
#pragma unroll
                            for (int j = 0; j < 8; ++j) o1[j] = kc[j] * __builtin_amdgcn_exp2f(fminf(Rb[kp][j] - cum[tt < NT ? tt : 0][kp][j], 115.f));
                            sc[hh] = MFMA16(pack8(o1), Qt[kp], sc[hh]);
                        }
                        if (tt == b) {
#pragma unroll
                            for (int r = 0; r < 4; ++r) if (4 * fq + r > lr) sc[hh][r] = 0.f;
                        }
                    }
                }
                const float pv[8] = {sc[0][0], sc[0][1], sc[0][2], sc[0][3], sc[1][0], sc[1][1], sc[1][2], sc[1][3]};
                const bf16x8 Pf = pack8(pv);
#pragma unroll
                for (int ne = 0; ne < 4; ++ne) O[ne] = MFMA16(tr_frag(vv, 32 * ks, 16 * ne, lane), Pf, O[ne]);
            }
        }
#if FRAG_PERM
#pragma unroll
        for (int ne = 0; ne < 4; ++ne) { Sf[ne][0] = frag_perm8(Sf[ne][0], lane); Sf[ne][1] = frag_perm8(Sf[ne][1], lane); }
#endif
#pragma unroll
        for (int ne = 0; ne < 4; ++ne) { O[ne] = MFMA16(Sf[ne][0], Qh[0], O[ne]); O[ne] = MFMA16(Sf[ne][1], Qh[1], O[ne]); }
        float sq = 0.f;
#pragma unroll
        for (int ne = 0; ne < 4; ++ne)
#pragma unroll
            for (int r = 0; r < 4; ++r) sq += O[ne][r] * O[ne][r];
        sq += shx(sq, 16, lane); sq += shx(sq, 32, lane);
        const float rstd = rsqrtf(sq * (1.f / 64.f) + LN_EPS);
#pragma unroll
        for (int ne = 0; ne < 4; ++ne) {
            const v2u gw = graw[b][ne];
            const float g0 = __uint_as_float(gw.x << 16), g1 = __uint_as_float(gw.x & 0xffff0000u), g2 = __uint_as_float(gw.y << 16), g3 = __uint_as_float(gw.y & 0xffff0000u);
            const float y0 = O[ne][0] * rstd * gq[ne][0] * g0 * sigmoidf_(g0), y1 = O[ne][1] * rstd * gq[ne][1] * g1 * sigmoidf_(g1);
            const float y2 = O[ne][2] * rstd * gq[ne][2] * g2 * sigmoidf_(g2), y3 = O[ne][3] * rstd * gq[ne][3] * g3 * sigmoidf_(g3);
            v2u o; o.x = pk2(y0, y1); o.y = pk2(y2, y3);
            *(v2u*)(ymix + (size_t)t * D + 16 * ne + 4 * fq) = o;
        }
    }
#undef HG_LOADQ
}

#ifndef MIXSEL
#define MIXSEL 7
#endif
#ifndef OLD_RG
#define OLD_RG 0
#endif
#ifndef PROBE_CHASE
#define PROBE_CHASE 0
#endif
#ifndef PROBE_RGREP
#define PROBE_RGREP 1
#endif
template <int PASS> DI void phase_mix(const Args& a, LAS unsigned char* lds, int layer, int sel = 7) {
    const int tid = fresh_tid(), lane = tid & 63, wave = __builtin_amdgcn_readfirstlane(tid >> 6);
    LAS unsigned char* wl = lds + wave * 16384;
    const int w = wave * (int)gridDim.x + fresh_bid();
    if (PASS == 1) {
#if PROBE_CHASE
        {
            const bf16_t* pp = (const bf16_t*)(a.ws + WS_PROJ); size_t idx = ((size_t)w * 6151 + lane * 8) % ((size_t)M * DIN - 64); float accp = 0.f;
#pragma unroll 1
            for (int k = 0; k < PROBE_CHASE; ++k) { const float v = bf2f(pp[idx]); accp += v; idx = (idx * 3 + 12345 + (size_t)(int)(v * 0.f)) % ((size_t)M * DIN - 64); }
            if (accp == 123456.789f) ((float*)(a.ws + WS_LS))[2000] = accp;
        }
#endif
#if MIX1_DEPHASE
#if MIX1_DEPHASE == 2
        const bool rg_first = (((fresh_bid() >> MIX1_DEPHASE_SHIFT) ^ (wave >> 2)) & 1) == 0;
#else
        const bool rg_first = ((fresh_bid() >> MIX1_DEPHASE_SHIFT) & 1) == 0;
#endif
        if (rg_first)
#endif
        if (sel & 4) rg_pass1<64>(a, wl, layer, w >> 3, w & 7, lane);
        if (w < 1024) { if (sel & 1) hg_pass1<64>(a, wl, layer, w >> 2, w & 3, lane); }
        else {
            const int s = w - 1024;
            if (sel & 2) ret_pass1<64>(a, wl, s >> 2, s & 3, lane);
            if (s < 128) { if (sel & 4) rg_pass1<32>(a, wl, layer, 256 + (s >> 3), s & 7, lane); }
            else if (s < 192) { if (sel & 1) hg_pass1<32>(a, wl, layer, 256 + ((s - 128) >> 2), (s - 128) & 3, lane); }
            else if (s < 256) { if (sel & 2) ret_pass1<32>(a, wl, 256 + ((s - 192) >> 2), (s - 192) & 3, lane); }
        }
#if MIX1_DEPHASE
        if (!rg_first) { if (sel & 4) rg_pass1<64>(a, wl, layer, w >> 3, w & 7, lane); }
#endif
    } else {
#if MIX2_REBALANCE
        if (w < 1024) {
            if (sel & 1) hg_pass2<64>(a, wl, layer, w >> 2, w & 3, lane);
            if (sel & 4) rg_pass2<64>(a, layer, w >> 3, w & 7, lane);
        } else {
            const int s = w - 1024;
            if (sel & 2) ret_pass2<64>(a, wl, layer, s >> 2, s & 3, lane);
            if (s < 64) { if (sel & 1) hg_pass2<32>(a, wl, layer, 256 + (s >> 2), s & 3, lane); }
            else if (s < 128) { if (sel & 2) ret_pass2<32>(a, wl, layer, 256 + ((s - 64) >> 2), (s - 64) & 3, lane); }
            else if (s < 256) { if (sel & 4) { const int u = s - 128; rg_pass2<32>(a, layer, 256 + (u >> 3), u & 7, lane); } }
            if (sel & 4) { const int u = 1024 + s; rg_pass2<64>(a, layer, u >> 3, u & 7, lane); }
        }
    }
}
#else
#if MIX2_DEPHASE
        const bool big_first = ((fresh_bid() >> 3) & 1) == 0;
#else
        const bool big_first = true;
#endif
        if (w < 1024) {
            if (big_first || MIX2_DEPHASE == 2) { if (sel & 1) hg_pass2<64>(a, wl, layer, w >> 2, w & 3, lane); }
            if (w < 256) { if (sel & 4) { const int u = 1792 + w; rg_pass2<64>(a, layer, u >> 3, u & 7, lane); } }
            else if (w < 384) { if (sel & 4) { const int u = w - 256; rg_pass2<32>(a, layer, 256 + (u >> 3), u & 7, lane); } }
            if (!big_first && MIX2_DEPHASE != 2) { if (sel & 1) hg_pass2<64>(a, wl, layer, w >> 2, w & 3, lane); }
        } else {
            const int s = w - 1024;
            if (big_first) { if (sel & 2) ret_pass2<64>(a, wl, layer, s >> 2, s & 3, lane); }
            if (s < 64) { if (sel & 1) hg_pass2<32>(a, wl, layer, 256 + (s >> 2), s & 3, lane); }
            else if (s < 128) { if (sel & 2) ret_pass2<32>(a, wl, layer, 256 + ((s - 64) >> 2), (s - 64) & 3, lane); }
            else if (sel & 4) {
#pragma unroll 1
                for (int k = 0; k < 2; ++k) { const int u = 2 * (s - 128) + k; rg_pass2<64>(a, layer, u >> 3, u & 7, lane); }
            }
            if (!big_first) { if (sel & 2) ret_pass2<64>(a, wl, layer, s >> 2, s & 3, lane); }
        }
    }
}
#endif

DI void phase_carry(const Args& a, int layer, int parts = 15) {
    const int gt = fresh_bid() * NTHREADS + fresh_tid(), NT = gridDim.x * NTHREADS;
    const float* CL = (const float*)(a.ws + WS_CL);
    const unsigned* U2 = (const unsigned*)(a.ws + WS_U); unsigned* ST2 = (unsigned*)(a.ws + WS_ST);
    const int gth = (gt >> 9) * 256 + (gt & 255), NTH = NT / 2;
    if ((gt & 256) == 0) {
        if (parts & 2)
        for (int idx = gth; idx < 4 * 8 * 2048; idx += NTH) {
            const int ep = idx & 2047, e = ep >> 5, d = (ep & 31) * 2, kh = (idx >> 11) & 7, q = idx >> 14, kind = kh >> 2, h = kh & 3;
            const float g64 = exp2f(64.f * ret_log2g(h));
            float S0 = 0.f, S1 = 0.f;
#if CARRY_ONE_ROUND
            if (kind == 0) {
                unsigned u[64];
#pragma unroll
                for (int j = 0; j < 64; ++j) { const int ch = q * 64 + j; u[j] = U2[((size_t)ch * 8 + kh) * 2048 + ep]; }
#pragma unroll
                for (int j = 0; j < 64; ++j) { const int ch = q * 64 + j; ST2[((size_t)ch * 8 + kh) * 2048 + ep] = pk2(S0, S1);
                    S0 = g64 * S0 + __uint_as_float(u[j] << 16); S1 = g64 * S1 + __uint_as_float(u[j] & 0xffff0000u); }
            } else {
#pragma unroll 1
                for (int c0 = 0; c0 < 64; c0 += CARRY_HG_CB) {
                    unsigned u[CARRY_HG_CB]; f32x2 dc[CARRY_HG_CB];
#pragma unroll
                    for (int j = 0; j < CARRY_HG_CB; ++j) { const int ch = q * 64 + c0 + j; u[j] = U2[((size_t)ch * 8 + kh) * 2048 + ep]; dc[j] = *(const f32x2*)(CL + (size_t)ch * 256 + h * 64 + d); }
#pragma unroll
                    for (int j = 0; j < CARRY_HG_CB; ++j) { const int ch = q * 64 + c0 + j; ST2[((size_t)ch * 8 + kh) * 2048 + ep] = pk2(S0, S1);
                        const float d0 = __builtin_amdgcn_exp2f(dc[j][0]), d1 = __builtin_amdgcn_exp2f(dc[j][1]);
                        S0 = d0 * S0 + __uint_as_float(u[j] << 16); S1 = d1 * S1 + __uint_as_float(u[j] & 0xffff0000u); }
                }
            }
#else
#pragma unroll 1
            for (int c0 = 0; c0 < 64; c0 += 32) {
                unsigned u[32]; f32x2 dc[32];
#pragma unroll
                for (int j = 0; j < 32; ++j) { const int ch = q * 64 + c0 + j; u[j] = LAST_USE_LD(U2 + ((size_t)ch * 8 + kh) * 2048 + ep); dc[j] = *(const f32x2*)(CL + (size_t)ch * 256 + h * 64 + d); }
#pragma unroll
                for (int j = 0; j < 32; ++j) { const int ch = q * 64 + c0 + j; ST2[((size_t)ch * 8 + kh) * 2048 + ep] = pk2(S0, S1);
                    const float d0 = __builtin_amdgcn_exp2f(dc[j][0]), d1 = __builtin_amdgcn_exp2f(dc[j][1]);
                    S0 = (kind ? d0 : g64) * S0 + __uint_as_float(u[j] << 16); S1 = (kind ? d1 : g64) * S1 + __uint_as_float(u[j] & 0xffff0000u); }
            }
#endif
            float* so = a.out + (kind ? O_HP : O_TP) + (((size_t)layer * 4 + q) * 4 + h) * 4096 + e;
            so[(size_t)d * 64] = S0; so[(size_t)(d + 1) * 64] = S1;
        }
    } else {
        const float* RGA = (const float*)(a.ws + WS_RGA); const float* RGB = (const float*)(a.ws + WS_RGB); float* HST = (float*)(a.ws + WS_HST);
        if ((parts & 1) && gth < 4 * 512) {
            const int cc = gth & 511, q = gth >> 9; float hh = 0.f;
#pragma unroll 1
            for (int c0 = 0; c0 < 64; c0 += CARRY_RG_CB) {
                float av[CARRY_RG_CB], bv[CARRY_RG_CB];
#pragma unroll
                for (int j = 0; j < CARRY_RG_CB; ++j) { const size_t o = (size_t)(q * 64 + c0 + j) * 512 + cc; av[j] = RGA[o]; bv[j] = RGB[o]; }
#pragma unroll
                for (int j = 0; j < CARRY_RG_CB; ++j) { const size_t o = (size_t)(q * 64 + c0 + j) * 512 + cc; HST[o] = hh; hh = av[j] * hh + bv[j]; }
            }
            a.out[O_RP + ((size_t)layer * 4 + q) * 512 + cc] = hh;
        } else if (gth >= 4096) {
            const int g2 = gth - 4096, NT2 = NTH - 4096;
            if (parts & 1)
            for (int idx = g2; idx < 16 * 512; idx += NT2) {
                const int cc = idx & 511, b = idx >> 9; const size_t o = (size_t)(256 + b) * 512 + cc;
                const float h0 = a.in[3][((size_t)layer * 16 + b) * 512 + cc];
                HST[o] = h0; a.out[O_RS + ((size_t)layer * 16 + b) * 512 + cc] = RGA[o] * h0 + RGB[o];
            }
#if CARRY_SAMPLE_BATCH
            if (parts & 4) {
                constexpr int NI = 5, NTOT = 16 * 8 * 2048;
                float s0v[NI], s1v[NI]; f32x2 clv[NI]; unsigned uv[NI];
#pragma unroll
                for (int k = 0; k < NI; ++k) {
                    const int idr = g2 + k * NT2, idx = idr < NTOT ? idr : g2;
                    const int ep = idx & 2047, e = ep >> 5, d = (ep & 31) * 2, kh = (idx >> 11) & 7, b = idx >> 14, kind = kh >> 2, h = kh & 3, ch = 256 + b;
                    const float* sin_ = a.in[kind ? 5 : 4] + (((size_t)layer * 16 + b) * 4 + h) * 4096 + e;
                    s0v[k] = sin_[(size_t)d * 64]; s1v[k] = sin_[(size_t)(d + 1) * 64];
                    clv[k] = *(const f32x2*)(CL + (size_t)ch * 256 + h * 64 + d);
                    uv[k] = U2[((size_t)ch * 8 + kh) * 2048 + ep];
                }
                __builtin_amdgcn_sched_barrier(0);
#pragma unroll
                for (int k = 0; k < NI; ++k) {
                    const int idx = g2 + k * NT2;
                    if (idx < NTOT) {
                        const int ep = idx & 2047, e = ep >> 5, d = (ep & 31) * 2, kh = (idx >> 11) & 7, b = idx >> 14, kind = kh >> 2, h = kh & 3, ch = 256 + b;
                        const float g32 = exp2f(32.f * ret_log2g(h));
                        const float dec0 = kind ? __builtin_amdgcn_exp2f(clv[k][0]) : g32, dec1 = kind ? __builtin_amdgcn_exp2f(clv[k][1]) : g32;
                        ST2[((size_t)ch * 8 + kh) * 2048 + ep] = pk2(s0v[k], s1v[k]);
                        float* so = a.out + (kind ? O_HS : O_TS) + (((size_t)layer * 16 + b) * 4 + h) * 4096 + e;
                        so[(size_t)d * 64] = dec0 * s0v[k] + __uint_as_float(uv[k] << 16); so[(size_t)(d + 1) * 64] = dec1 * s1v[k] + __uint_as_float(uv[k] & 0xffff0000u);
                    }
                }
            }
#else
            if (parts & 4)
            for (int idx = g2; idx < 16 * 8 * 2048; idx += NT2) {
                const int ep = idx & 2047, e = ep >> 5, d = (ep & 31) * 2, kh = (idx >> 11) & 7, b = idx >> 14, kind = kh >> 2, h = kh & 3, ch = 256 + b;
                const float* sin_ = a.in[kind ? 5 : 4] + (((size_t)layer * 16 + b) * 4 + h) * 4096 + e;
                const float S0 = sin_[(size_t)d * 64], S1 = sin_[(size_t)(d + 1) * 64];
                const f32x2 cl = *(const f32x2*)(CL + (size_t)ch * 256 + h * 64 + d);
                const float g32 = exp2f(32.f * ret_log2g(h));
                const float dec0 = kind ? __builtin_amdgcn_exp2f(cl[0]) : g32, dec1 = kind ? __builtin_amdgcn_exp2f(cl[1]) : g32;
                const unsigned u = U2[((size_t)ch * 8 + kh) * 2048 + ep];
                ST2[((size_t)ch * 8 + kh) * 2048 + ep] = pk2(S0, S1);
                float* so = a.out + (kind ? O_HS : O_TS) + (((size_t)layer * 16 + b) * 4 + h) * 4096 + e;
                so[(size_t)d * 64] = dec0 * S0 + __uint_as_float(u << 16); so[(size_t)(d + 1) * 64] = dec1 * S1 + __uint_as_float(u & 0xffff0000u);
            }
#endif
            const bf16_t* proj = (const bf16_t*)(a.ws + WS_PROJ);
            if (parts & 8)
            for (int idx = g2; idx < NSEQ * 3 * 512; idx += NT2) {
                const int cc = idx & 511, j = (idx >> 9) % 3, q = idx / (3 * 512);
                const float v = bf2f(proj[(size_t)(seq_row0(q) + seq_len(q) - 3 + j) * DIN + C_RGX + cc]);
                if (q < NB) a.out[O_CP + (((size_t)layer * 4 + q) * 3 + j) * 512 + cc] = v; else a.out[O_CS + (((size_t)layer * 16 + (q - NB)) * 3 + j) * 512 + cc] = v;
            }
        }
    }
}

DI void phase_tables(const Args& a) {
    const int gt = fresh_bid() * NTHREADS + fresh_tid(), NT = gridDim.x * NTHREADS;
#if STATS_FUSED
    { v4u ones; ones.x = ones.y = ones.z = ones.w = ~0u; v4u* xs = (v4u*)(a.ws + WS_XBUF);
      for (int idx = gt; idx < (int)(2 * XBUF_LAYER / 16); idx += NT) xs[idx] = ones; }
#endif
    float* rcos = (float*)(a.ws + WS_ROPE); float* rsin = rcos + 4096 * 32;
    for (int idx = gt; idx < 4096 * 32; idx += NT) {
        const int pos = idx >> 5, i = idx & 31;
        const float inv = exp2f(-(float)i * (13.287712379549449f / 32.f));
        float sn, cs; sincosf((float)pos * inv, &sn, &cs);
        rcos[idx] = cs; rsin[idx] = sn;
    }
    for (int idx = gt; idx < 2 * 512; idx += NT) ((float*)(a.ws + WS_LS))[idx] = -16.f * log1pf(__expf(-a.in[13][idx]));
    for (int idx = gt; idx < 2 * 256; idx += NT) { const int l = idx >> 8, j = idx & 255; ((float*)(a.ws + WS_LBT))[idx] = l ? 1.f / (1.f + __expf(a.in[16][j] - a.in[16][256 + j])) : 0.f; }
    bf16_t* gwt = (bf16_t*)(a.ws + WS_GATEW);
    for (int idx = gt; idx < 2 * 2 * 8 * 4096; idx += NT) {
        const int cin = idx & 63, cc = (idx >> 6) & 63, g = (idx >> 12) & 7, which = (idx >> 15) & 1, l = idx >> 16;
        gwt[idx] = f2bf(-1.4426950408889634f * a.in[which ? 11 : 9][(((size_t)l * 8 + g) * 64 + cin) * 64 + cc]);
    }
}
#ifndef ONE_LAUNCH
#define ONE_LAUNCH 1
#endif
#if !ONE_LAUNCH
template <int PH> __global__ void __launch_bounds__(NTHREADS, 2) k_ph(Args a) {
    extern __shared__ __attribute__((aligned(16))) unsigned char lds_raw[];
    LAS unsigned char* lds = (LAS unsigned char*)lds_raw;
    park_wave_index();
    __syncthreads();
    if (PH == 0) { phase_prologue(a, lds); phase_tables(a); }
    else if (PH == 1) phase_gemm_in(a, lds, a.layer);
    else if (PH == 2) phase_mix<1>(a, lds, a.layer);
    else if (PH == 3) phase_carry(a, a.layer);
    else if (PH == 4) phase_mix<2>(a, lds, a.layer);
    else if (PH == 5) phase_gemm_out(a, lds, a.layer);
    else if (PH == 6) phase_sample_final_ln(a);
}
template <int PH> static void launch_ph(int grid, hipStream_t stream, const Args& a) {
    static bool attr = false;
    if (!attr) { (void)hipFuncSetAttribute((const void*)k_ph<PH>, hipFuncAttributeMaxDynamicSharedMemorySize, LDS_BYTES); attr = true; }
    hipLaunchKernelGGL(k_ph<PH>, dim3(grid), dim3(NTHREADS), LDS_BYTES, stream, a);
}

#endif
#ifndef PROBE_DUP
#define PROBE_DUP 0
#endif
#ifndef PROBE_TIME
#define PROBE_TIME -1
#endif
#if PROBE_TIME >= 0
#ifndef PROBE_TIME_B
#define PROBE_TIME_B (PROBE_TIME + 1)
#endif
#define PSTAMP(k_) do { if (fresh_bid() == 0 && fresh_tid() == 0) { const unsigned long long t_ = __builtin_amdgcn_s_memrealtime(); volatile LAS unsigned* ms_ = (volatile LAS unsigned*)(lds + MISC_OFF + 512); ms_[2 * (k_)] = (unsigned)t_; ms_[1 + 2 * (k_)] = (unsigned)(t_ >> 32); } } while (0)
#define PTIME_READOUT() do { if (fresh_bid() == 0) { __syncthreads(); volatile LAS unsigned* ms_ = (volatile LAS unsigned*)(lds + MISC_OFF + 512); \
        const unsigned long long t0_ = ((unsigned long long)ms_[1 + 2 * PROBE_TIME] << 32) | ms_[2 * PROBE_TIME], t1_ = ((unsigned long long)ms_[1 + 2 * (PROBE_TIME_B)] << 32) | ms_[2 * (PROBE_TIME_B)]; \
        const float sc_ = 1.f + (float)(t1_ - t0_) * 1e-5f; \
        for (int i_ = fresh_tid(); i_ < 2 * 16 * 3 * 512; i_ += NTHREADS) a.out[O_CS + i_] *= sc_; } } while (0)
#else
#define PSTAMP(k_) do { } while (0)
#define PTIME_READOUT() do { } while (0)
#endif
__global__ void __launch_bounds__(NTHREADS, 2) mega(Args a) {
    extern __shared__ __attribute__((aligned(16))) unsigned char lds_raw[];
    LAS unsigned char* lds = (LAS unsigned char*)lds_raw;
    volatile LAS unsigned* misc = (volatile LAS unsigned*)(lds + MISC_OFF);
    if (threadIdx.x < 32) misc[threadIdx.x] = 0u;
    park_wave_index();
    __syncthreads();
    (void)xcd_barrier_post((unsigned*)(a.ws + WS_CTL) + CW_BAR, misc + 8);
    PSTAMP(0);
    phase_prologue(a, lds); phase_tables(a);
    grid_barrier(a, lds);
    PSTAMP(1);
    if (PROBE_DUP == 6) { phase_prologue(a, lds); phase_tables(a); grid_barrier(a, lds); }
    if (PROBE_DUP == 20) {
#pragma unroll 1
        for (int i = 0; i < 20; ++i) grid_barrier(a, lds);
    }
#pragma unroll 1
    for (int layer = 0; layer < DEPTH; ++layer) {
        phase_gemm_in(a, lds, layer);
        grid_barrier(a, lds);
        PSTAMP(2 + 5 * layer);
        if (PROBE_DUP == 1) { phase_gemm_in(a, lds, layer); grid_barrier(a, lds); }
        phase_mix<1>(a, lds, layer);
        grid_barrier(a, lds);
        PSTAMP(3 + 5 * layer);
        if (PROBE_DUP == 2) { phase_mix<1>(a, lds, layer); grid_barrier(a, lds); }
        if (PROBE_DUP >= 7 && PROBE_DUP <= 9) { phase_mix<1>(a, lds, layer, 1 << (PROBE_DUP - 7)); grid_barrier(a, lds); }
        phase_carry(a, layer);
        grid_barrier(a, lds);
        PSTAMP(4 + 5 * layer);
        if (PROBE_DUP == 3) { phase_carry(a, layer); grid_barrier(a, lds); }
        if (PROBE_DUP >= 30 && PROBE_DUP < 46) { phase_carry(a, layer, PROBE_DUP - 30); grid_barrier(a, lds); }
        phase_mix<2>(a, lds, layer);
        grid_barrier(a, lds);
        PSTAMP(5 + 5 * layer);
        if (PROBE_DUP == 4) { phase_mix<2>(a, lds, layer); grid_barrier(a, lds); }
        if (PROBE_DUP >= 10 && PROBE_DUP <= 12) { phase_mix<2>(a, lds, layer, 1 << (PROBE_DUP - 10)); grid_barrier(a, lds); }
        phase_gemm_out(a, lds, layer);
        if (PROBE_DUP == 5) { grid_barrier(a, lds); phase_gemm_out(a, lds, layer); }
#if FINAL_LN_INLINE
        if (layer + 1 < DEPTH) grid_barrier(a, lds);
        PSTAMP(6 + 5 * layer);
    }
    PTIME_READOUT();
#else
        grid_barrier(a, lds);
    }
    phase_sample_final_ln(a);
#endif
}

#ifndef ONE_LAUNCH
#define ONE_LAUNCH 1
#endif
#ifndef NAIVE_RG
#define NAIVE_RG 0
#endif
#ifndef NAIVE_RET
#define NAIVE_RET 0
#endif
#ifndef NAIVE_HG
#define NAIVE_HG 0
#endif

extern "C" void kernel_launch(void* const* d_in, const int* in_sizes, int n_in, void* d_out, int out_size, void* d_ws, size_t ws_size, hipStream_t stream) {
    static int grid = 0;
    if (grid == 0) {
        int dev = 0, cus = 0;
        (void)hipGetDevice(&dev); (void)hipDeviceGetAttribute(&cus, hipDeviceAttributeMultiprocessorCount, dev);
        int per_cu = 0;
        (void)hipFuncSetAttribute((const void*)mega, hipFuncAttributeMaxDynamicSharedMemorySize, LDS_BYTES);
        if (hipOccupancyMaxActiveBlocksPerMultiprocessor(&per_cu, (const void*)mega, NTHREADS, LDS_BYTES) != hipSuccess || per_cu < 1)
            fprintf(stderr, "kernel_launch: occupancy query reports %d workgroups per CU for the megakernel\n", per_cu);
        (void)hipGetLastError();
        grid = cus;
        if (n_in != 21 || out_size != (int)O_END || ws_size < WS_END) fprintf(stderr, "kernel_launch: unexpected sizes n_in %d out %d ws %zu\n", n_in, out_size, ws_size);
    }
    const float* const* in = (const float* const*)d_in;
    unsigned char* ws = (unsigned char*)d_ws;
    float* out = (float*)d_out;
    (void)hipMemsetAsync(ws + WS_CTL, 0, CTL_ZERO_BYTES, stream);
#if defined(PROBE_MEMSET2)
    for (int i_ = 0; i_ < PROBE_MEMSET2; ++i_) (void)hipMemsetAsync(ws + WS_CTL, 0, CTL_ZERO_BYTES, stream);
#endif
    Args a{};
    for (int i = 0; i < 21; ++i) a.in[i] = in[i];
    a.out = out; a.ws = ws;
    bf16_t* PROJ = (bf16_t*)(ws + WS_PROJ); bf16_t* YMIX = (bf16_t*)(ws + WS_YMIX);
    (void)PROJ; (void)YMIX;
#if ONE_LAUNCH
    hipLaunchKernelGGL(mega, dim3(grid), dim3(NTHREADS), LDS_BYTES, stream, a);
#endif
#if !ONE_LAUNCH
    a.phase = 0; a.layer = 0;
    launch_ph<0>(grid, stream, a);
    for (int l = 0; l < DEPTH; ++l) {
        a.layer = l;
        launch_ph<1>(grid, stream, a); launch_ph<2>(grid, stream, a); launch_ph<3>(grid, stream, a); launch_ph<4>(grid, stream, a);
#if NAIVE_RG
        k_rg_naive<<<NSEQ * 8, 64, 0, stream>>>(PROJ, YMIX, in[2] + (size_t)l * 16 * 3 * 512, in[3] + (size_t)l * 16 * 512, in[7] + l * 4 * 512, in[8] + l * 512,
                                                in[9] + (size_t)l * 8 * 64 * 64, in[10] + l * 512, in[11] + (size_t)l * 8 * 64 * 64, in[12] + l * 512, in[13] + l * 512, out, l);
#endif
#if NAIVE_RET
        k_lin_naive<false><<<NSEQ * 4, 256, 0, stream>>>(PROJ, YMIX, in[4] + (size_t)l * 16 * 4 * 4096, in[14] + l * 256, nullptr, nullptr, out, l);
#endif
#if NAIVE_HG
        k_lin_naive<true><<<NSEQ * 4, 256, 0, stream>>>(PROJ, YMIX, in[5] + (size_t)l * 16 * 4 * 4096, in[17] + l * 256, in[15] + l * 256, in[16], out, l);
#endif
        launch_ph<5>(grid, stream, a);
    }
    launch_ph<6>(grid, stream, a);
#endif
}
```
